# Optimizing an MI355X kernel written in HIP

```python
import jax, jax.numpy as jnp
from jax import lax
import numpy as np

D_MODEL = 1024
BATCH = 8
SEQ = 2048
DEPTH = 2
DEC_BATCH = 32
DEC_SEQ = 4
PAST_LEN = 16384
PAGE_SIZE = 128

N_A_LAYERS = DEPTH // 2
N_B_LAYERS = DEPTH - N_A_LAYERS
H_A = 16
D_NOPE = 64
D_ROPE = 32
D_V = 64
D_QC = 384
D_C = 256
D_CKV = D_C + D_ROPE
SCALE_A = (D_NOPE + D_ROPE) ** -0.5
H_B = 16
N_KV_B = 4
HD_B = 64
G_B = H_B // N_KV_B
WINDOW = 128
ROT_B = HD_B // 4
SCALE_B = HD_B ** -0.5
D_FF_RAW = -(-8 * D_MODEL // 3)
D_FF = ((D_FF_RAW + 255) // 256) * 256
ROPE_THETA = 500000.0
Q_BLOCK = 128
EPS = 1e-6
NEG = -1e30

kernel_name = 'yoco_mla_swa_sink_decoder_step'


def rms_norm(x, g):
    xf = x.astype(jnp.float32)
    y = xf * lax.rsqrt(jnp.mean(xf * xf, axis=-1, keepdims=True) + EPS)
    return (y * g.astype(jnp.float32)).astype(x.dtype)


def rope_cos_sin(pos, n_rot):
    inv = ROPE_THETA ** (-jnp.arange(0, n_rot, 2, dtype=jnp.float32) / n_rot)
    ang = pos.astype(jnp.float32)[:, None] * inv[None, :]
    return jnp.cos(ang), jnp.sin(ang)


def apply_rope(x, cos, sin):
    r = cos.shape[-1]
    x1 = x[..., :r].astype(jnp.float32)
    x2 = x[..., r:2 * r].astype(jnp.float32)
    c = cos[:, None, :]
    s = sin[:, None, :]
    rot = jnp.concatenate([x1 * c - x2 * s, x2 * c + x1 * s], axis=-1).astype(x.dtype)
    return jnp.concatenate([rot, x[..., 2 * r:]], axis=-1)


def swiglu(hn, w_in, w_out):
    a = hn @ w_in
    return (jax.nn.silu(a[..., :D_FF]) * a[..., D_FF:]) @ w_out


def sink_softmax(s, sink):
    sk = jnp.broadcast_to(sink, s.shape[:-1] + (1,))
    p = jax.nn.softmax(jnp.concatenate([s, sk], axis=-1), axis=-1)
    return p[..., :-1]


def mla_project(hn, pos, w_in, g_qc, w_uq, g_ckv, g_qn, g_qr, g_kr):
    b, s, _ = hn.shape
    a = hn @ w_in
    c_q = rms_norm(a[..., :D_QC], g_qc)
    c_kv = rms_norm(a[..., D_QC:D_QC + D_C], g_ckv)
    k_pe = a[..., D_QC + D_C:][:, :, None, :]
    q = (c_q @ w_uq).reshape(b, s, H_A, D_NOPE + D_ROPE)
    cos, sin = rope_cos_sin(pos, D_ROPE)
    q_nope = rms_norm(q[..., :D_NOPE], g_qn)
    q_pe = apply_rope(rms_norm(q[..., D_NOPE:], g_qr), cos, sin)
    k_pe = apply_rope(rms_norm(k_pe, g_kr), cos, sin)[:, :, 0]
    rows = jnp.concatenate([c_kv, k_pe], axis=-1)
    return q_nope, q_pe, rows


def mla_keys(rows, w_uk, g_kn):
    c = rows[..., :D_C]
    k_nope = jnp.einsum('bsc,chd->bshd', c, w_uk.reshape(D_C, H_A, D_NOPE))
    return rms_norm(k_nope, g_kn), rows[..., D_C:]


def mla_scores(q_nope, q_pe, k_nope, k_pe):
    s = jnp.einsum('bqhd,bshd->bhqs', q_nope, k_nope) + jnp.einsum('bqhr,bsr->bhqs', q_pe, k_pe)
    return s.astype(jnp.float32) * SCALE_A


def mla_prompt_attn(q_nope, q_pe, rows, w_uk, w_uv, g_kn):
    b, s_len = q_nope.shape[:2]
    nb = s_len // Q_BLOCK
    k_nope, k_pe = mla_keys(rows, w_uk, g_kn)
    v = jnp.einsum('bsc,chd->bshd', rows[..., :D_C], w_uv.reshape(D_C, H_A, D_V))
    qn = q_nope.reshape(b, nb, Q_BLOCK, H_A, D_NOPE).transpose(1, 0, 2, 3, 4)
    qp = q_pe.reshape(b, nb, Q_BLOCK, H_A, D_ROPE).transpose(1, 0, 2, 3, 4)
    k_pos = jnp.arange(s_len)

    def block(args):
        i, qn_b, qp_b = args
        sc = mla_scores(qn_b, qp_b, k_nope, k_pe)
        q_pos = i * Q_BLOCK + jnp.arange(Q_BLOCK)
        sc = jnp.where(k_pos[None, :] <= q_pos[:, None], sc, NEG)
        p = jax.nn.softmax(sc, axis=-1).astype(v.dtype)
        return jnp.einsum('bhqs,bshd->bqhd', p, v)

    o = lax.map(block, (jnp.arange(nb), qn, qp))
    return o.transpose(1, 0, 2, 3, 4).reshape(b, s_len, H_A * D_V)


def online_softmax_update(carry, s, vals):
    m, l, acc = carry
    m_new = jnp.maximum(m, jnp.max(s, axis=-1))
    corr = jnp.exp(m - m_new)
    p = jnp.exp(s - m_new[..., None])
    return (m_new, l * corr + jnp.sum(p, axis=-1),
            acc * corr[..., None] + jnp.einsum('bhts,bsc->bhtc', p, vals))


def mla_paged_attn(q_nope, q_pe, new_rows, cache_l, page_table, w_uk, w_uv, g_kn):
    bd, t = q_nope.shape[:2]
    f32 = jnp.float32
    init = (jnp.full((bd, H_A, t), NEG, f32), jnp.zeros((bd, H_A, t), f32),
            jnp.zeros((bd, H_A, t, D_C), f32))

    def page_step(carry, page_ids):
        rows = cache_l[page_ids]
        k_nope, k_pe = mla_keys(rows, w_uk, g_kn)
        sc = mla_scores(q_nope, q_pe, k_nope, k_pe)
        return online_softmax_update(carry, sc, rows[..., :D_C].astype(f32)), None

    carry, _ = lax.scan(page_step, init, page_table.T)
    k_nope, k_pe = mla_keys(new_rows, w_uk, g_kn)
    sc = mla_scores(q_nope, q_pe, k_nope, k_pe)
    sc = jnp.where(jnp.tril(jnp.ones((t, t), dtype=bool)), sc, NEG)
    _, l, acc = online_softmax_update(carry, sc, new_rows[..., :D_C].astype(f32))
    o_lat = acc / l[..., None]
    o = jnp.einsum('bhtc,chd->bthd', o_lat, w_uv.reshape(D_C, H_A, D_V).astype(f32))
    return o.astype(q_nope.dtype).reshape(bd, t, H_A * D_V)


def shared_kv(h, pos, g_kv, w_kv, g_k):
    b, s, _ = h.shape
    kv = rms_norm(h, g_kv) @ w_kv
    k = kv[..., :N_KV_B * HD_B].reshape(b, s, N_KV_B, HD_B)
    v = kv[..., N_KV_B * HD_B:].reshape(b, s, N_KV_B, HD_B)
    cos, sin = rope_cos_sin(pos, ROT_B)
    return apply_rope(rms_norm(k, g_k), cos, sin), v


def swa_query(hn, pos, w_q, g_q):
    b, s, _ = hn.shape
    q = rms_norm((hn @ w_q).reshape(b, s, H_B, HD_B), g_q)
    cos, sin = rope_cos_sin(pos, ROT_B)
    return apply_rope(q, cos, sin)


def swa_banded_attn(q, k, v, sink):
    b, s_len = q.shape[:2]
    nb = s_len // WINDOW
    qb = q.reshape(b, nb, WINDOW, N_KV_B, G_B, HD_B)

    def band(z):
        zp = jnp.concatenate([jnp.zeros_like(z[:, :WINDOW]), z[:, :s_len - WINDOW]], axis=1)
        return jnp.concatenate([zp.reshape(b, nb, WINDOW, N_KV_B, HD_B),
                                z.reshape(b, nb, WINDOW, N_KV_B, HD_B)], axis=2)

    kb, vb = band(k), band(v)
    sc = jnp.einsum('bnqkgd,bnskd->bnkgqs', qb, kb).astype(jnp.float32) * SCALE_B
    blk = jnp.arange(nb)[:, None, None]
    q_rel = jnp.arange(WINDOW)[None, :, None] + WINDOW
    k_rel = jnp.arange(2 * WINDOW)[None, None, :]
    diff = q_rel - k_rel
    valid = (diff >= 0) & (diff < WINDOW) & (blk * WINDOW - WINDOW + k_rel >= 0)
    sc = jnp.where(valid[None, :, None, None], sc, NEG)
    p = sink_softmax(sc, sink.astype(jnp.float32).reshape(N_KV_B, G_B)[None, None, :, :, None, None])
    o = jnp.einsum('bnkgqs,bnskd->bnqkgd', p.astype(v.dtype), vb)
    return o.reshape(b, s_len, H_B * HD_B)


def swa_explicit_attn(q, q_pos, k, v, k_pos, sink):
    bd, t = q.shape[:2]
    qg = q.reshape(bd, t, N_KV_B, G_B, HD_B)
    sc = jnp.einsum('btkgd,bskd->bkgts', qg, k).astype(jnp.float32) * SCALE_B
    diff = q_pos[:, None] - k_pos[None, :]
    sc = jnp.where((diff >= 0) & (diff < WINDOW), sc, NEG)
    p = sink_softmax(sc, sink.astype(jnp.float32).reshape(N_KV_B, G_B)[None, :, :, None, None])
    o = jnp.einsum('bkgts,bskd->btkgd', p.astype(v.dtype), v)
    return o.reshape(bd, t, H_B * HD_B)


def setup_inputs(seed: int = 0) -> dict:
    key = jax.random.key(seed)
    ks = iter(jax.random.split(key, 48))
    f32 = jnp.float32

    def w(shape, fan_in):
        return jax.random.normal(next(ks), shape, f32) * fan_in ** -0.5

    def gain(shape):
        return 1.0 + 0.02 * jax.random.normal(next(ks), shape, f32)

    def act(shape):
        return jax.random.normal(next(ks), shape, f32)

    n_pages = PAST_LEN // PAGE_SIZE
    n_used = DEC_BATCH * n_pages
    n_pool = n_used + (n_used + 3) // 4
    w_buf = min(WINDOW, PAST_LEN)
    perm = jax.random.permutation(next(ks), n_pool)
    page_table = perm[:n_used].reshape(DEC_BATCH, n_pages).astype(jnp.int32)
    return {
        'x_prompt': act((BATCH, SEQ, D_MODEL)),
        'x_sample': act((DEC_BATCH, DEC_SEQ, D_MODEL)),
        'cache_mla': act((N_A_LAYERS, n_pool, PAGE_SIZE, D_CKV)),
        'state_win_k': act((DEC_BATCH, w_buf, N_KV_B, HD_B)),
        'state_win_v': act((DEC_BATCH, w_buf, N_KV_B, HD_B)),
        'page_table': page_table,
        'norm_attn': gain((DEPTH, D_MODEL)),
        'norm_ffn': gain((DEPTH, D_MODEL)),
        'w_a_in': w((N_A_LAYERS, D_MODEL, D_QC + D_C + D_ROPE), D_MODEL),
        'g_qc': gain((N_A_LAYERS, D_QC)),
        'w_uq': w((N_A_LAYERS, D_QC, H_A * (D_NOPE + D_ROPE)), D_QC),
        'g_ckv': gain((N_A_LAYERS, D_C)),
        'w_uk': w((N_A_LAYERS, D_C, H_A * D_NOPE), D_C),
        'w_uv': w((N_A_LAYERS, D_C, H_A * D_V), D_C),
        'g_qn_a': gain((N_A_LAYERS, D_NOPE)),
        'g_qr_a': gain((N_A_LAYERS, D_ROPE)),
        'g_kn_a': gain((N_A_LAYERS, D_NOPE)),
        'g_kr_a': gain((N_A_LAYERS, D_ROPE)),
        'w_a_out': w((N_A_LAYERS, H_A * D_V, D_MODEL), H_A * D_V),
        'g_kv_shared': gain((D_MODEL,)),
        'w_kv_shared': w((D_MODEL, 2 * N_KV_B * HD_B), D_MODEL),
        'g_k_b': gain((HD_B,)),
        'w_q_b': w((N_B_LAYERS, D_MODEL, H_B * HD_B), D_MODEL),
        'g_q_b': gain((N_B_LAYERS, HD_B)),
        'sinks': 0.5 * act((N_B_LAYERS, H_B)),
        'w_b_out': w((N_B_LAYERS, H_B * HD_B, D_MODEL), H_B * HD_B),
        'w_ffn_in': w((DEPTH, D_MODEL, 2 * D_FF), D_MODEL),
        'w_ffn_out': w((DEPTH, D_FF, D_MODEL), D_FF),
    }


def reference(x_prompt, x_sample, cache_mla, state_win_k, state_win_v, page_table,
              norm_attn, norm_ffn, w_a_in, g_qc, w_uq, g_ckv, w_uk, w_uv,
              g_qn_a, g_qr_a, g_kn_a, g_kr_a, w_a_out,
              g_kv_shared, w_kv_shared, g_k_b, w_q_b, g_q_b, sinks, w_b_out,
              w_ffn_in, w_ffn_out):
    seq = x_prompt.shape[1]
    dec_seq = x_sample.shape[1]
    past_len = page_table.shape[1] * PAGE_SIZE
    w_buf = state_win_k.shape[1]
    pos_p = jnp.arange(seq)
    pos_s = past_len + jnp.arange(dec_seq)

    def trunk(x, pos, mla_attend, swa_attend):
        h = x
        rows_all = []
        k_sh = None
        v_sh = None
        for l in range(DEPTH):
            hn = rms_norm(h, norm_attn[l])
            if l < N_A_LAYERS:
                q_nope, q_pe, rows = mla_project(hn, pos, w_a_in[l], g_qc[l], w_uq[l], g_ckv[l],
                                                 g_qn_a[l], g_qr_a[l], g_kr_a[l])
                h = h + mla_attend(l, q_nope, q_pe, rows) @ w_a_out[l]
                rows_all.append(rows)
            else:
                if l == N_A_LAYERS:
                    k_sh, v_sh = shared_kv(h, pos, g_kv_shared, w_kv_shared, g_k_b)
                lb = l - N_A_LAYERS
                q = swa_query(hn, pos, w_q_b[lb], g_q_b[lb])
                h = h + swa_attend(q, k_sh, v_sh, sinks[lb]) @ w_b_out[lb]
            h = h + swiglu(rms_norm(h, norm_ffn[l]), w_ffn_in[l], w_ffn_out[l])
        return h, jnp.stack(rows_all), k_sh, v_sh

    def mla_attend_prompt(la, q_nope, q_pe, rows):
        return mla_prompt_attn(q_nope, q_pe, rows, w_uk[la], w_uv[la], g_kn_a[la])

    def mla_attend_sample(la, q_nope, q_pe, rows):
        return mla_paged_attn(q_nope, q_pe, rows, cache_mla[la], page_table,
                              w_uk[la], w_uv[la], g_kn_a[la])

    def swa_attend_sample(q, k, v, sink):
        k_all = jnp.concatenate([state_win_k, k], axis=1)
        v_all = jnp.concatenate([state_win_v, v], axis=1)
        k_pos = jnp.concatenate([past_len - w_buf + jnp.arange(w_buf), pos_s])
        return swa_explicit_attn(q, pos_s, k_all, v_all, k_pos, sink)

    y_prompt, rows_p, k_p, v_p = trunk(x_prompt, pos_p, mla_attend_prompt, swa_banded_attn)
    y_sample, rows_s, k_s, v_s = trunk(x_sample, pos_s, mla_attend_sample, swa_attend_sample)

    w_p = min(WINDOW, seq)
    win_k_p = k_p[:, seq - w_p:]
    win_v_p = v_p[:, seq - w_p:]
    win_k_s = jnp.concatenate([state_win_k, k_s], axis=1)[:, -w_buf:]
    win_v_s = jnp.concatenate([state_win_v, v_s], axis=1)[:, -w_buf:]
    return (y_prompt, y_sample, rows_p, rows_s, win_k_p, win_v_p, win_k_s, win_v_s)
```

```cpp
#include <hip/hip_runtime.h>
#include <hip/hip_cooperative_groups.h>
#include <cstdio>
#include <cstdint>
#include <cmath>
namespace cg = cooperative_groups;
#define LAS __attribute__((address_space(3)))
typedef unsigned short bf16_t;
typedef short bf16x8 __attribute__((ext_vector_type(8)));
typedef float f32x4 __attribute__((ext_vector_type(4)));
typedef float f32x16 __attribute__((ext_vector_type(16)));
typedef unsigned u32x2 __attribute__((ext_vector_type(2)));
typedef unsigned u32x4 __attribute__((ext_vector_type(4)));

namespace mk {
constexpr int DM = 1024, NB = 8, SEQ = 2048, DB = 32, DS = 4, PAST = 16384, PAGE = 128, NPAGES = 128;
constexpr int TP = NB * SEQ, TS = DB * DS, T = TP + TS;
constexpr int HA = 16, DQC = 384, DC = 256, DCKV = 288, DQH = 96;
constexpr int HB = 16, NKV = 4, WIN = 128, DFF = 2816;
constexpr float EPS = 1e-6f;
constexpr int NPOS = SEQ + DS;
constexpr float LOG2E = 1.4426950408889634f;
constexpr float SCALE_A = 0.10206207261596575f, SCALE_B = 0.125f;
constexpr int NWAVES = 8, NTHR = 512;

__device__ __forceinline__ unsigned f2bf(float f) { unsigned u = __builtin_bit_cast(unsigned, f); return (u + 0x7fffu + ((u >> 16) & 1u)) >> 16; }
typedef float f32x2_t __attribute__((ext_vector_type(2))); typedef __bf16 bf16x2_t __attribute__((ext_vector_type(2)));
__device__ __forceinline__ unsigned pk2(float lo, float hi) { const f32x2_t v = {lo, hi}; const bf16x2_t b = __builtin_convertvector(v, bf16x2_t); return __builtin_bit_cast(unsigned, b); }
__device__ __forceinline__ float bf2f(unsigned b) { return __builtin_bit_cast(float, b << 16); }
__device__ __forceinline__ float bflo(unsigned w) { return __builtin_bit_cast(float, w << 16); }
__device__ __forceinline__ float bfhi(unsigned w) { return __builtin_bit_cast(float, w & 0xffff0000u); }
__device__ __forceinline__ float wave_sum(float v) {
#pragma unroll
    for (int o = 1; o < 64; o <<= 1) v += __shfl_xor(v, o);
    return v;
}
__device__ __forceinline__ int lane_id_fresh() { int l; asm volatile("v_mbcnt_lo_u32_b32 %0, -1, 0\n\tv_mbcnt_hi_u32_b32 %0, -1, %0" : "=v"(l)); return l; }
__device__ __forceinline__ int tok_pidx(int t) { return t < TP ? (t % SEQ) : (SEQ + (t - TP) % DS); }

#define XB_TMO      128
#define XB_XCNT(j)  (256  + 64 * (j))
#define XB_XSUB(j)  (1280 + 64 * (j))
#define XB_XGEN(j)  (2304 + 64 * (j))
#define XB_TOP      3328
#define XB_TOPGEN   3392
#define XCD_BAR_WORDS 3456
#define XB_SPIN_CAP (1u << 18)
__device__ __forceinline__ unsigned xb_ld(unsigned* p)              { return __hip_atomic_load(p, __ATOMIC_RELAXED, __HIP_MEMORY_SCOPE_AGENT); }
__device__ __forceinline__ unsigned xb_add(unsigned* p, unsigned v) { return __hip_atomic_fetch_add(p, v, __ATOMIC_RELAXED, __HIP_MEMORY_SCOPE_AGENT); }
__device__ __forceinline__ unsigned xb_xcc_id() { return (unsigned)__builtin_amdgcn_s_getreg((3 << 11) | 20) & 0xFu; }
#define XB_SPIN(cond, bar) do { unsigned _sp = 0; while (cond) { __builtin_amdgcn_s_sleep(1); \
    if ((++_sp & 255u) == 0u) { if (xb_ld(&(bar)[XB_TMO])) break; if (_sp > XB_SPIN_CAP) { atomicAdd(&(bar)[XB_TMO], 1u); break; } } } } while (0)
struct XcdBarrier { unsigned* bar; unsigned x; volatile LAS unsigned* st; };
__device__ __forceinline__ XcdBarrier xcd_barrier_post(unsigned* bar, volatile LAS unsigned* st) {
    XcdBarrier b; b.bar = bar; b.x = xb_xcc_id(); b.st = st;
    if (threadIdx.x == 0) (void)xb_add(&bar[XB_XCNT(b.x)], 1u);
    return b;
}
__device__ __forceinline__ void xcd_barrier_complete(unsigned* bar, unsigned x, unsigned& nloc, unsigned& nx) {
    const unsigned G = gridDim.x * gridDim.y * gridDim.z;
    unsigned sum, cnt, mine, sp = 0u;
    for (;;) {
        sum = 0u; cnt = 0u; mine = 0u;
#pragma unroll
        for (unsigned j = 0; j < 16; ++j) { const unsigned c = xb_ld(&bar[XB_XCNT(j)]); sum += c; cnt += (c > 0u) ? 1u : 0u; mine = (j == x) ? c : mine; }
        if (sum == G) break;
        __builtin_amdgcn_s_sleep(1);
        if ((++sp & 255u) == 0u) { if (xb_ld(&bar[XB_TMO])) break; if (sp > XB_SPIN_CAP) { atomicAdd(&bar[XB_TMO], 1u); break; } }
    }
    nloc = mine > 0u ? mine : 1u; nx = cnt > 0u ? cnt : 1u;
}
__device__ __forceinline__ void xcd_barrier(const XcdBarrier& b) {
    asm volatile("s_waitcnt vmcnt(0)" ::: "memory");
    __syncthreads();
    if (threadIdx.x == 0) {
        unsigned* bar = b.bar;
        __builtin_amdgcn_s_waitcnt(0);
        unsigned nloc = b.st[0], nx = b.st[1];
        if (nloc == 0u) { xcd_barrier_complete(bar, b.x, nloc, nx); b.st[0] = nloc; b.st[1] = nx; }
        const unsigned old = xb_add(&bar[XB_XSUB(b.x)], 1u);
        const unsigned gen = old / nloc;
        if (old + 1u == (gen + 1u) * nloc) {
            __builtin_amdgcn_fence(__ATOMIC_RELEASE, "agent");
            asm volatile("s_waitcnt vmcnt(0)" ::: "memory");
            const unsigned og = xb_add(&bar[XB_TOP], 1u);
            const unsigned tg = og / nx;
            if (og + 1u == (tg + 1u) * nx) xb_add(&bar[XB_TOPGEN], 1u);
            else XB_SPIN(xb_ld(&bar[XB_TOPGEN]) == tg, bar);
            __builtin_amdgcn_fence(__ATOMIC_ACQUIRE, "agent");
            xb_add(&bar[XB_XGEN(b.x)], 1u);
            asm volatile("s_waitcnt vmcnt(0)" ::: "memory");
        } else {
            XB_SPIN(xb_ld(&bar[XB_XGEN(b.x)]) == gen, bar);
            __builtin_amdgcn_fence(__ATOMIC_ACQUIRE, "agent");
            asm volatile("s_waitcnt vmcnt(0)" ::: "memory");
        }
    }
    __syncthreads();
}
}
namespace pg8 {
#define PG8_LAS __attribute__((address_space(3)))
constexpr int BM = 256, BK = 64, HALF = 128, HTB = HALF * BK * 2, STAGE_BYTES = 8 * HTB, NXCD = 8, WGM = 8;
__host__ __device__ __forceinline__ int lds_byte(int r, int c) { const int st = (r >> 4) * 2 + (c >> 5), rr = r & 15, cc = c & 31, ob = rr * 64 + cc * 2; return st * 1024 + (ob ^ (((ob >> 9) & 1) << 5)); }
__host__ __device__ __forceinline__ void stage_rc(int b, int& R, int& C) { const int st = b / 1024, sb = b % 1024, swz = sb ^ (((sb >> 9) & 1) << 5); R = (st >> 1) * 16 + swz / 64; C = (st & 1) * 32 + (swz % 64) / 2; }
__host__ __device__ __forceinline__ int perm32(int rho) { const int n = rho >> 4, i = rho & 15; return 8 * (i >> 2) + 4 * n + (i & 3); }

struct Unit { int pm, pn; };
struct Gemm { const bf16_t* A; const bf16_t* Bt; int M, N, K; };

struct StaticOrder {
    int nM, nN, nwg, G, c;
    __host__ __device__ void init(int M, int N, int G_, int c_) { nM = M / BM; nN = N / BM; nwg = nM * nN; G = G_; c = c_; }
    __host__ __device__ bool next(int i, Unit& u) const {
        const long L = (long)i * G + c; if (L >= nwg) return false;
        int wgid = (int)L; { const int q = nwg / NXCD, r = nwg % NXCD, xcd = wgid % NXCD, off = wgid / NXCD; wgid = (xcd < r ? xcd * (q + 1) : r * (q + 1) + (xcd - r) * q) + off; }
        const int nig = WGM * nN, gid = wgid / nig, fm = gid * WGM, gsz = (nM - fm) < WGM ? (nM - fm) : WGM;
        u.pm = fm + ((wgid % nig) % gsz); u.pn = (wgid % nig) / gsz; return true;
    }
    __device__ __forceinline__ void a_ready(const Unit&) const {}
    __device__ __forceinline__ void done(const Unit&) const {}
};
template <class Epi, class Sched, bool ALIGN_EPI = false, bool SP2 = false>
__device__ __forceinline__ void gemm_phase(PG8_LAS unsigned char* lds, const Gemm g, const Sched& S, const Epi& E, const int wave_id) {
    const int lane = mk::lane_id_fresh(), wid = wave_id, tid = wid * 64 + lane,     wr = wid >> 2, wc = wid & 3, fr = lane & 15, fq = lane >> 4;
    const int K = g.K, nt = K / BK;
    unsigned voffA[2], voffB[2];
#pragma unroll
    for (int i = 0; i < 2; ++i) { int R, C; stage_rc(tid * 16 + i * 8192, R, C); const int Rb = Epi::PERM ? ((R & ~31) + perm32(R & 31)) : R;
        voffA[i] = (unsigned)(R * K + C) * 2u; voffB[i] = (unsigned)(Rb * K + C) * 2u; }
    const size_t kstep = (size_t)(BK * 2);
    const size_t hstep = (size_t)HALF * K * 2;
    const size_t tstep = 2 * hstep;
    const unsigned ldsw = (unsigned)wid * 1024u;
    const int aoff = lds_byte(wr * 64 + fr, fq * 8), boff = lds_byte(wc * 32 + fr, fq * 8);
#define PG8_SA(b, h) (((b) * 2 + (h)) * HTB)
#define PG8_SB(b, h) ((4 + (b) * 2 + (h)) * HTB)
#define PG8_STAGE(bufoff, gbase, voff) do { _Pragma("unroll") for (int _i = 0; _i < 2; ++_i) \
        __builtin_amdgcn_global_load_lds((const unsigned*)((const char*)(gbase) + (voff)[_i]), (PG8_LAS unsigned*)(lds + (bufoff) + ldsw + _i * 8192), 16, 0, 0); } while (0)
#define PG8_LDA(dst, b, h) do { _Pragma("unroll") for (int m = 0; m < 4; ++m) _Pragma("unroll") for (int k = 0; k < 2; ++k) dst[m][k] = *(const PG8_LAS bf16x8*)(lds + PG8_SA(b, h) + aoff + m * 2048 + k * 1024); } while (0)
#define PG8_LDB(dst, b, h) do { _Pragma("unroll") for (int n = 0; n < 2; ++n) _Pragma("unroll") for (int k = 0; k < 2; ++k) dst[n][k] = *(const PG8_LAS bf16x8*)(lds + PG8_SB(b, h) + boff + n * 2048 + k * 1024); } while (0)
#define PG8_MMA(ai, bj, At, Bt) do { __builtin_amdgcn_s_setprio(1); _Pragma("unroll") for (int m = 0; m < 4; ++m) _Pragma("unroll") for (int n = 0; n < 2; ++n) _Pragma("unroll") for (int k = 0; k < 2; ++k) \
        acc[ai][bj][m][n] = __builtin_amdgcn_mfma_f32_16x16x32_bf16(Bt[n][k], At[m][k], acc[ai][bj][m][n], 0, 0, 0); __builtin_amdgcn_s_setprio(0); } while (0)
#define PG8_WAIT_V(n) asm volatile("s_waitcnt vmcnt(" #n ")" ::: "memory")
#define PG8_WAIT_L(n) asm volatile("s_waitcnt lgkmcnt(" #n ")" ::: "memory")
#define PG8_BAR __builtin_amdgcn_s_barrier()
#define PG8_SCHED __builtin_amdgcn_sched_barrier(0)
    Unit cur, nxt; int ui = 0;
    if (!S.next(0, cur)) return;
    f32x4 acc[2][2][4][2];
#pragma unroll
    for (int a = 0; a < 2; ++a)
#pragma unroll
        for (int b = 0; b < 2; ++b)
#pragma unroll
            for (int m = 0; m < 4; ++m)
#pragma unroll
                for (int n = 0; n < 2; ++n) acc[a][b][m][n] = (f32x4){0.f, 0.f, 0.f, 0.f};
    bf16x8 At[4][2], B0[2][2], B1[2][2];
    const char* cA = (const char*)g.A + (size_t)cur.pm * tstep; const char* cB = (const char*)g.Bt + (size_t)cur.pn * tstep;
    S.a_ready(cur);
    if constexpr (SP2) {
        PG8_STAGE(PG8_SB(0, 0), cB, voffB); PG8_STAGE(PG8_SB(0, 1), cB + hstep, voffB); PG8_STAGE(PG8_SA(0, 0), cA, voffA); PG8_STAGE(PG8_SA(0, 1), cA + hstep, voffA);
        if (wr == 1) PG8_BAR;
        PG8_WAIT_V(2); PG8_BAR;
        PG8_STAGE(PG8_SB(1, 0), cB + kstep, voffB); PG8_STAGE(PG8_SA(1, 0), cA + kstep, voffA); PG8_STAGE(PG8_SB(1, 1), cB + hstep + kstep, voffB);
        PG8_WAIT_V(6); PG8_BAR;
    } else {
        PG8_STAGE(PG8_SB(0, 0), cB, voffB); PG8_STAGE(PG8_SA(0, 0), cA, voffA); PG8_STAGE(PG8_SB(0, 1), cB + hstep, voffB); PG8_STAGE(PG8_SA(0, 1), cA + hstep, voffA);
        if (wr == 1) PG8_BAR;
        PG8_WAIT_V(4); PG8_BAR;
        PG8_STAGE(PG8_SB(1, 0), cB + kstep, voffB); PG8_STAGE(PG8_SA(1, 0), cA + kstep, voffA); PG8_STAGE(PG8_SB(1, 1), cB + hstep + kstep, voffB);
        PG8_WAIT_V(6); PG8_BAR;
    }
    for (;;) {
        const bool has_next = S.next(ui + 1, nxt);
        const char* nA = has_next ? (const char*)g.A + (size_t)nxt.pm * tstep : cA; const char* nB = has_next ? (const char*)g.Bt + (size_t)nxt.pn * tstep : cB;
        for (int t = 0; t < nt; t += 2) {
            const bool last = (t == nt - 2);
            const char* a1 = cA + (size_t)(t + 1) * kstep;
            const char* a2 = last ? nA : cA + (size_t)(t + 2) * kstep; const char* b2 = last ? nB : cB + (size_t)(t + 2) * kstep;
            const char* a3 = a2 + kstep; const char* b3 = b2 + kstep;
            if (last && has_next) S.a_ready(nxt);
            if constexpr (SP2) {
            PG8_LDB(B0, 0, 0); PG8_LDB(B1, 0, 1); PG8_SCHED; PG8_LDA(At, 0, 0); PG8_STAGE(PG8_SA(1, 1), a1 + hstep, voffA);
            PG8_WAIT_V(8); PG8_WAIT_L(0); PG8_BAR; PG8_MMA(0, 0, At, B0); PG8_MMA(0, 1, At, B1); PG8_BAR; PG8_SCHED;
            PG8_LDA(At, 0, 1); PG8_STAGE(PG8_SB(0, 0), b2, voffB); PG8_STAGE(PG8_SB(0, 1), b2 + hstep, voffB); PG8_STAGE(PG8_SA(0, 0), a2, voffA);
            PG8_WAIT_V(8); PG8_WAIT_L(0); PG8_BAR; PG8_MMA(1, 0, At, B0); PG8_MMA(1, 1, At, B1); PG8_BAR; PG8_SCHED;
            PG8_LDB(B0, 1, 0); PG8_LDB(B1, 1, 1); PG8_SCHED; PG8_LDA(At, 1, 0); PG8_STAGE(PG8_SA(0, 1), a2 + hstep, voffA);
            PG8_WAIT_V(8); PG8_WAIT_L(0); PG8_BAR; PG8_MMA(0, 0, At, B0); PG8_MMA(0, 1, At, B1); PG8_BAR; PG8_SCHED;
            PG8_LDA(At, 1, 1); PG8_STAGE(PG8_SB(1, 0), b3, voffB); PG8_STAGE(PG8_SB(1, 1), b3 + hstep, voffB); PG8_STAGE(PG8_SA(1, 0), a3, voffA);
            PG8_WAIT_V(8); PG8_WAIT_L(0); PG8_BAR; PG8_MMA(1, 0, At, B0); PG8_MMA(1, 1, At, B1); PG8_BAR; PG8_SCHED;
            } else {
            PG8_LDB(B0, 0, 0); PG8_SCHED; PG8_LDA(At, 0, 0); PG8_STAGE(PG8_SA(1, 1), a1 + hstep, voffA);
            PG8_WAIT_L(8); PG8_BAR; PG8_WAIT_L(0); PG8_MMA(0, 0, At, B0); PG8_BAR; PG8_SCHED;
            PG8_LDB(B1, 0, 1); PG8_STAGE(PG8_SB(0, 0), b2, voffB);
            PG8_BAR; PG8_WAIT_L(0); PG8_MMA(0, 1, At, B1); PG8_BAR;
            PG8_LDA(At, 0, 1); PG8_STAGE(PG8_SA(0, 0), a2, voffA);
            PG8_BAR; PG8_WAIT_L(0); PG8_MMA(1, 0, At, B0); PG8_BAR; PG8_SCHED;
            PG8_STAGE(PG8_SB(0, 1), b2 + hstep, voffB);
            PG8_WAIT_V(6); PG8_BAR; PG8_MMA(1, 1, At, B1); PG8_BAR;
            PG8_LDB(B0, 1, 0); PG8_SCHED; PG8_LDA(At, 1, 0); PG8_STAGE(PG8_SA(0, 1), a2 + hstep, voffA);
            PG8_WAIT_L(8); PG8_BAR; PG8_WAIT_L(0); PG8_MMA(0, 0, At, B0); PG8_BAR; PG8_SCHED;
            PG8_LDB(B1, 1, 1); PG8_STAGE(PG8_SB(1, 0), b3, voffB);
            PG8_BAR; PG8_WAIT_L(0); PG8_MMA(0, 1, At, B1); PG8_BAR;
            PG8_LDA(At, 1, 1); PG8_STAGE(PG8_SA(1, 0), a3, voffA);
            PG8_BAR; PG8_WAIT_L(0); PG8_MMA(1, 0, At, B0); PG8_BAR; PG8_SCHED;
            PG8_STAGE(PG8_SB(1, 1), b3 + hstep, voffB);
            PG8_WAIT_V(6); PG8_BAR; PG8_MMA(1, 1, At, B1); PG8_BAR;
            }
        }
        if constexpr (ALIGN_EPI) { if (wr == 0) PG8_BAR; }
        if constexpr (!Epi::AFTER_DRAIN) { E(acc, cur, wr, wc, fr, fq); S.done(cur); }
        if (!has_next) break;
#pragma unroll
        for (int a = 0; a < 2; ++a)
#pragma unroll
            for (int b = 0; b < 2; ++b)
#pragma unroll
                for (int m = 0; m < 4; ++m)
#pragma unroll
                    for (int n = 0; n < 2; ++n) acc[a][b][m][n] = (f32x4){0.f, 0.f, 0.f, 0.f};
        cur = nxt; cA = nA; cB = nB; ++ui;
        if constexpr (ALIGN_EPI) { if (wr == 1) PG8_BAR; }
    }
    PG8_WAIT_V(0);
    if constexpr (!ALIGN_EPI) { if (wr == 0) PG8_BAR; }
    PG8_BAR;
    if constexpr (Epi::AFTER_DRAIN) { E.fused(acc, cur, wr, wc, fr, fq, lds, wid, lane); S.done(cur); }
#undef PG8_SA
#undef PG8_SB
#undef PG8_STAGE
#undef PG8_LDA
#undef PG8_LDB
#undef PG8_MMA
#undef PG8_WAIT_V
#undef PG8_WAIT_L
#undef PG8_BAR
#undef PG8_SCHED
}
}
namespace mk {
using pg8::Unit;
__device__ __forceinline__ float ss_to_r(float ss) { return rsqrtf(ss * (1.f / DM) + EPS); }
__device__ __forceinline__ u32x2 pk4(f32x4 v) { return (u32x2){pk2(v[0], v[1]), pk2(v[2], v[3])}; }
__device__ __forceinline__ float sq4(f32x4 v) { return (v[0] * v[0] + v[1] * v[1]) + (v[2] * v[2] + v[3] * v[3]); }
__device__ __forceinline__ float quad_sum(float s) { s += __shfl_xor(s, 16); s += __shfl_xor(s, 32); return s; }
struct FStoreF32 { float* out; int ldc;
    __device__ __forceinline__ void rowquad(int row, int ct, int wc, int fq, f32x4 a00, f32x4 a01, f32x4 a10, f32x4 a11) const {
        float* p = out + (size_t)row * ldc + ct + 32 * wc + 4 * fq; *(f32x4*)p = a00; *(f32x4*)(p + 16) = a01; *(f32x4*)(p + 128) = a10; *(f32x4*)(p + 144) = a11; } };
template <int RES, bool OUTF> struct FResid { float* out; const float* resf; bf16_t* hb; float* ss;
    __device__ __forceinline__ f32x4 ld(size_t o) const { if (RES == 0) return *(const f32x4*)(resf + o); const u32x2 r = *(const u32x2*)(hb + o); return (f32x4){bflo(r.x), bfhi(r.x), bflo(r.y), bfhi(r.y)}; }
    __device__ __forceinline__ void rowquad(int row, int ct, int wc, int fq, f32x4 a00, f32x4 a01, f32x4 a10, f32x4 a11) const {
        const size_t o = (size_t)row * DM + ct + 32 * wc + 4 * fq;
        a00 += ld(o); a01 += ld(o + 16); a10 += ld(o + 128); a11 += ld(o + 144);
        if (OUTF) { *(f32x4*)(out + o) = a00; *(f32x4*)(out + o + 16) = a01; *(f32x4*)(out + o + 128) = a10; *(f32x4*)(out + o + 144) = a11; }
        else { *(u32x2*)(hb + o) = pk4(a00); *(u32x2*)(hb + o + 16) = pk4(a01); *(u32x2*)(hb + o + 128) = pk4(a10); *(u32x2*)(hb + o + 144) = pk4(a11);
            const float st = quad_sum((sq4(a00) + sq4(a01)) + (sq4(a10) + sq4(a11))); if (fq == 0) atomicAdd(ss + row, st); } } };
__device__ __forceinline__ float silu_f(float g) { return g * __builtin_amdgcn_rcpf(1.0f + __expf(-g)); }
struct FSwiglu { bf16_t* out; const float* ss;
    __device__ __forceinline__ void rowquad(int row, int ct, int wc, int fq, f32x4 a00, f32x4 a01, f32x4 a10, f32x4 a11) const {
#ifdef EXP_NOEPI
        { const f32x4 sm = (a00 + a01) + (a10 + a11); if (sm[0] + sm[1] + sm[2] + sm[3] == 12345.678f) out[row] = 1; return; }
#endif
#ifdef EXP_NOSS
        const float rs = 1.f;
#else
        const float rs = ss_to_r(ss[row]);
#endif
        a00 *= rs; a01 *= rs; a10 *= rs; a11 *= rs;
        bf16_t* p = out + (size_t)row * DFF + (ct >> 1) + 32 * wc + 4 * fq;
        *(u32x2*)p = (u32x2){pk2(silu_f(a00[0]) * a10[0], silu_f(a00[1]) * a10[1]), pk2(silu_f(a00[2]) * a10[2], silu_f(a00[3]) * a10[3])};
        *(u32x2*)(p + 16) = (u32x2){pk2(silu_f(a01[0]) * a11[0], silu_f(a01[1]) * a11[1]), pk2(silu_f(a01[2]) * a11[2], silu_f(a01[3]) * a11[3])}; } };
__device__ __forceinline__ void head_store4(bf16_t* p, const float* g, float rn, f32x4 a00, f32x4 a01, f32x4 a10, f32x4 a11) {
    *(u32x2*)p = pk4(a00 * rn * *(const f32x4*)g); asm volatile("" ::: "memory");
    *(u32x2*)(p + 16) = pk4(a01 * rn * *(const f32x4*)(g + 16)); asm volatile("" ::: "memory");
    *(u32x2*)(p + 32) = pk4(a10 * rn * *(const f32x4*)(g + 32)); asm volatile("" ::: "memory");
    *(u32x2*)(p + 48) = pk4(a11 * rn * *(const f32x4*)(g + 48)); }
struct FPostA { bf16_t* cq; bf16_t* ckv; bf16_t* kpe; float* ssq; float* sskv; float* rows; const float* g_qc; const float* g_ckv; const float* g_kr; const float* cosA; const float* sinA;
    __device__ __forceinline__ void rowquad(int row, int ct, int wc, int fq, f32x4 a00, f32x4 a01, f32x4 a10, f32x4 a11) const {
        const int pn = ct >> 8, cb = 32 * wc + 4 * fq;
        if (pn == 0) { const float st = quad_sum((sq4(a00) + sq4(a01)) + (sq4(a10) + sq4(a11))); if (fq == 0) atomicAdd(ssq + row, st);
            bf16_t* p = cq + (size_t)row * DQC + cb; const float* g = g_qc + cb;
            *(u32x2*)p = pk4(a00 * *(const f32x4*)g); *(u32x2*)(p + 16) = pk4(a01 * *(const f32x4*)(g + 16)); *(u32x2*)(p + 128) = pk4(a10 * *(const f32x4*)(g + 128)); *(u32x2*)(p + 144) = pk4(a11 * *(const f32x4*)(g + 144)); }
        else if (pn == 2) { const float st = quad_sum((sq4(a00) + sq4(a01)) + (sq4(a10) + sq4(a11))); if (fq == 0) atomicAdd(sskv + row, st);
            bf16_t* p = ckv + (size_t)row * DC + cb; const float* g = g_ckv + cb;
            *(u32x2*)p = pk4(a00 * *(const f32x4*)g); *(u32x2*)(p + 16) = pk4(a01 * *(const f32x4*)(g + 16)); *(u32x2*)(p + 128) = pk4(a10 * *(const f32x4*)(g + 128)); *(u32x2*)(p + 144) = pk4(a11 * *(const f32x4*)(g + 144)); }
        else { const float st = quad_sum(sq4(a00) + sq4(a01)); if (fq == 0) atomicAdd(ssq + row, st);
            bf16_t* p = cq + (size_t)row * DQC + 256 + cb; const float* g = g_qc + 256 + cb;
            *(u32x2*)p = pk4(a00 * *(const f32x4*)g); *(u32x2*)(p + 16) = pk4(a01 * *(const f32x4*)(g + 16));
            if (wc == 0) { const float r = rsqrtf(quad_sum(sq4(a10) + sq4(a11)) * (1.f / 32) + EPS); const int pi = tok_pidx(row);
                const f32x4 v1 = a10 * r * *(const f32x4*)(g_kr + 4 * fq), v2 = a11 * r * *(const f32x4*)(g_kr + 16 + 4 * fq);
                const f32x4 c = *(const f32x4*)(cosA + pi * 16 + 4 * fq), s = *(const f32x4*)(sinA + pi * 16 + 4 * fq);
                const f32x4 o1 = v1 * c - v2 * s, o2 = v2 * c + v1 * s;
                *(u32x2*)(kpe + (size_t)row * 32 + 4 * fq) = pk4(o1); *(u32x2*)(kpe + (size_t)row * 32 + 16 + 4 * fq) = pk4(o2);
                *(f32x4*)(rows + (size_t)row * DCKV + DC + 4 * fq) = o1; *(f32x4*)(rows + (size_t)row * DCKV + DC + 16 + 4 * fq) = o2; } } } };
struct FMlaQN { bf16_t* qf; const float* g_qn; const float* ssq;
    __device__ __forceinline__ void rowquad(int row, int ct, int wc, int fq, f32x4 a00, f32x4 a01, f32x4 a10, f32x4 a11) const {
        { const float rq = rsqrtf(ssq[row] * (1.f / DQC) + EPS); a00 *= rq; a01 *= rq; a10 *= rq; a11 *= rq; }
        const int head = (ct >> 6) + wc; const float rn = rsqrtf(quad_sum((sq4(a00) + sq4(a01)) + (sq4(a10) + sq4(a11))) * (1.f / 64) + EPS) * (SCALE_A * LOG2E);
        head_store4(qf + ((size_t)row * 16 + head) * 96 + 4 * fq, g_qn + 4 * fq, rn, a00, a01, a10, a11); } };
struct FMlaQR { bf16_t* qf; const float* g_qr; const float* cosA; const float* sinA; const float* ssq;
    __device__ __forceinline__ void half(int row, int head, int fq, f32x4 x1, f32x4 x2) const {
        { const float rq = rsqrtf(ssq[row] * (1.f / DQC) + EPS); x1 *= rq; x2 *= rq; }
        const float r = rsqrtf(quad_sum(sq4(x1) + sq4(x2)) * (1.f / 32) + EPS) * (SCALE_A * LOG2E);
        const int pi = tok_pidx(row);
        x1 = x1 * r * *(const f32x4*)(g_qr + 4 * fq); x2 = x2 * r * *(const f32x4*)(g_qr + 16 + 4 * fq);
        const f32x4 c = *(const f32x4*)(cosA + pi * 16 + 4 * fq), s = *(const f32x4*)(sinA + pi * 16 + 4 * fq);
        bf16_t* p = qf + ((size_t)row * 16 + head) * 96 + 64 + 4 * fq; *(u32x2*)p = pk4(x1 * c - x2 * s); *(u32x2*)(p + 16) = pk4(x2 * c + x1 * s);
        asm volatile("" ::: "memory"); }
    __device__ __forceinline__ void rowquad(int row, int ct, int wc, int fq, f32x4 a00, f32x4 a01, f32x4 a10, f32x4 a11) const {
        const int h0 = 8 * (ct >> 8) + wc; half(row, h0, fq, a00, a01); half(row, h0 + 4, fq, a10, a11); } };
struct FKnV { bf16_t* kn; bf16_t* knv; const float* g_kn; const float* sskv;
    __device__ __forceinline__ void rowquad(int row, int ct, int wc, int fq, f32x4 a00, f32x4 a01, f32x4 a10, f32x4 a11) const {
        { const float rk = rsqrtf(sskv[row] * (1.f / DC) + EPS); a00 *= rk; a01 *= rk; a10 *= rk; a11 *= rk; }
        if (ct < 1024) { const int head = (ct >> 6) + wc; const float rn = rsqrtf(quad_sum((sq4(a00) + sq4(a01)) + (sq4(a10) + sq4(a11))) * (1.f / 64) + EPS);
            head_store4(kn + (size_t)row * 1024 + head * 64 + 4 * fq, g_kn + 4 * fq, rn, a00, a01, a10, a11); }
        else { bf16_t* p = knv + (size_t)row * 2048 + ct + 32 * wc + 4 * fq; *(u32x2*)p = pk4(a00); *(u32x2*)(p + 16) = pk4(a01); *(u32x2*)(p + 128) = pk4(a10); *(u32x2*)(p + 144) = pk4(a11); } } };
struct FKvq { bf16_t* ks; bf16_t* vs; bf16_t* qbf; const float* ss; const float* g_k; const float* g_q; const float* cosB; const float* sinB; float* out;
    __device__ __forceinline__ void winptr(int row, float*& wk, float*& wv) const {
        float* out_wkp = out + (size_t)T * DM + (size_t)T * DCKV; float* out_wvp = out_wkp + (size_t)NB * WIN * 256; float* out_wks = out_wvp + (size_t)NB * WIN * 256; float* out_wvs = out_wks + (size_t)DB * WIN * 256;
        wk = nullptr; wv = nullptr;
        if (row < TP) { const int b = row / SEQ, s = row % SEQ; if (s >= SEQ - WIN) { wk = out_wkp + ((size_t)b * WIN + (s - (SEQ - WIN))) * 256; wv = out_wvp + ((size_t)b * WIN + (s - (SEQ - WIN))) * 256; } }
        else { const int b = (row - TP) / DS, tt = (row - TP) % DS; wk = out_wks + ((size_t)b * WIN + (WIN - DS) + tt) * 256; wv = out_wvs + ((size_t)b * WIN + (WIN - DS) + tt) * 256; } }
    __device__ __forceinline__ void rowquad(int row, int ct, int wc, int fq, f32x4 a00, f32x4 a01, f32x4 a10, f32x4 a11) const {
        const float rs = ss_to_r(ss[row]); a00 *= rs; a01 *= rs; a10 *= rs; a11 *= rs;
        const int pn = ct >> 8;
        if (pn == 1) { float* wk; float* wv; winptr(row, wk, wv); const int cb = 32 * wc + 4 * fq;
            bf16_t* p = vs + (size_t)row * 256 + cb; *(u32x2*)p = pk4(a00); *(u32x2*)(p + 16) = pk4(a01); *(u32x2*)(p + 128) = pk4(a10); *(u32x2*)(p + 144) = pk4(a11);
            if (wv) { *(f32x4*)(wv + cb) = a00; *(f32x4*)(wv + cb + 16) = a01; *(f32x4*)(wv + cb + 128) = a10; *(f32x4*)(wv + cb + 144) = a11; }
            return; }
        const bool isk = pn == 0; const float* g = (isk ? g_k : g_q) + 4 * fq;
        const float rn = rsqrtf(quad_sum((sq4(a00) + sq4(a01)) + (sq4(a10) + sq4(a11))) * (1.f / 64) + EPS) * (isk ? 1.f : SCALE_B * LOG2E);
        a00 = a00 * rn * *(const f32x4*)g; a01 = a01 * rn * *(const f32x4*)(g + 16); a10 = a10 * rn * *(const f32x4*)(g + 32); a11 = a11 * rn * *(const f32x4*)(g + 48);
        { const int pi = tok_pidx(row); const f32x4 c = *(const f32x4*)(cosB + pi * 8 + 4 * (fq & 1)), s = *(const f32x4*)(sinB + pi * 8 + 4 * (fq & 1));
          f32x4 other; other[0] = __shfl_xor(a00[0], 32); other[1] = __shfl_xor(a00[1], 32); other[2] = __shfl_xor(a00[2], 32); other[3] = __shfl_xor(a00[3], 32);
          a00 = (fq < 2) ? (a00 * c - other * s) : (a00 * c + other * s); }
        if (isk) { float* wk; float* wv; winptr(row, wk, wv); const int cb = 64 * wc + 4 * fq;
            bf16_t* p = ks + (size_t)row * 256 + cb; *(u32x2*)p = pk4(a00); *(u32x2*)(p + 16) = pk4(a01); *(u32x2*)(p + 32) = pk4(a10); *(u32x2*)(p + 48) = pk4(a11);
            if (wk) { *(f32x4*)(wk + cb) = a00; *(f32x4*)(wk + cb + 16) = a01; *(f32x4*)(wk + cb + 32) = a10; *(f32x4*)(wk + cb + 48) = a11; } }
        else { bf16_t* p = qbf + (size_t)row * 1024 + (4 * (pn - 2) + wc) * 64 + 4 * fq; *(u32x2*)p = pk4(a00); *(u32x2*)(p + 16) = pk4(a01); *(u32x2*)(p + 32) = pk4(a10); *(u32x2*)(p + 48) = pk4(a11); } } };

template <class F> struct EpiAdapt {
    static constexpr bool PERM = false, AFTER_DRAIN = false; F f;
    __device__ __forceinline__ void operator()(const f32x4 (&acc)[2][2][4][2], const Unit& u, int wr, int wc, int fr, int fq) const {
        asm volatile("" : "+v"(fr), "+v"(fq));
#pragma unroll
        for (int ai = 0; ai < 2; ++ai)
#pragma unroll
            for (int m = 0; m < 4; ++m) { f.rowquad(u.pm * 256 + ai * 128 + wr * 64 + m * 16 + fr, u.pn * 256, wc, fq, acc[ai][0][m][0], acc[ai][0][m][1], acc[ai][1][m][0], acc[ai][1][m][1]); asm volatile("" ::: "memory"); }
    }
    __device__ __forceinline__ void fused(f32x4 (&)[2][2][4][2], const Unit&, int, int, int, int, PG8_LAS unsigned char*, int, int) const {}
};

template <class F, bool AL = true, bool SP = true> __device__ __forceinline__ void big_gemm(LAS unsigned char* lds, const bf16_t* A, const bf16_t* Bt, int M, int N, int K, const F& f, int wave_id) {
    pg8::Gemm g{A, Bt, M, N, K}; pg8::StaticOrder S; S.init(M, N, (int)gridDim.x, (int)blockIdx.x);
    EpiAdapt<F> E{f};
    pg8::gemm_phase<EpiAdapt<F>, pg8::StaticOrder, AL, SP>(lds, g, S, E, wave_id);
}
template <class F> __device__ __forceinline__ void skinny_gemm(LAS unsigned char* lds, const bf16_t* A, const bf16_t* Bt, int N, int K, const F& f, int wave, int lane_unused, int blk0 = 0) {
    const int lane = lane_id_fresh(); (void)lane_unused;
    const int fr = lane & 15, fq = lane >> 4, ntask = N / 8, nks = K / 32;
    LAS f32x4* red = (LAS f32x4*)lds;
    if ((int)blockIdx.x < blk0) return;
    for (int task = blockIdx.x - blk0; task < ntask; task += gridDim.x - blk0) {
        const int rg = task & 7, wc = (task >> 3) & 3, pn = task >> 5;
        const bf16_t* ap = A + (size_t)(TP + 16 * rg + fr) * K + 8 * fq;
        const bf16_t* bp = Bt + (size_t)(256 * pn + 32 * wc + fr) * K + 8 * fq;
        f32x4 acc[2][2];
#pragma unroll
        for (int bj = 0; bj < 2; ++bj)
#pragma unroll
            for (int n = 0; n < 2; ++n) acc[bj][n] = (f32x4){0.f, 0.f, 0.f, 0.f};
#pragma unroll 2
        for (int ks = wave; ks < nks; ks += 8) {
            const bf16x8 a = *(const bf16x8*)(ap + 32 * ks);
#pragma unroll
            for (int bj = 0; bj < 2; ++bj)
#pragma unroll
                for (int n = 0; n < 2; ++n) { const bf16x8 b = *(const bf16x8*)(bp + (size_t)(128 * bj + 16 * n) * K + 32 * ks);
                    acc[bj][n] = __builtin_amdgcn_mfma_f32_16x16x32_bf16(b, a, acc[bj][n], 0, 0, 0); }
        }
#pragma unroll
        for (int bj = 0; bj < 2; ++bj)
#pragma unroll
            for (int n = 0; n < 2; ++n) red[(wave * 4 + bj * 2 + n) * 64 + lane] = acc[bj][n];
        __syncthreads();
        if (wave == 0) {
            f32x4 v[4];
#pragma unroll
            for (int q = 0; q < 4; ++q) { v[q] = (f32x4){0.f, 0.f, 0.f, 0.f};
#pragma unroll
                for (int ww = 0; ww < 8; ++ww) v[q] += red[(ww * 4 + q) * 64 + lane]; }
            f.rowquad(TP + 16 * rg + fr, 256 * pn, wc, fq, v[0], v[1], v[2], v[3]);
        }
        __syncthreads();
    }
}

template <class F> __device__ __forceinline__ void wave_gemm64(const bf16_t* A, int M, const bf16_t* Bt, int N, int K, const F& f, int gw, int ngw, int lane_unused) {
    const int lane = lane_id_fresh(); (void)lane_unused;
    const int fr = lane & 15, fq = lane >> 4, ncol = N / 64, ntask = (M / 64) * ncol;
    for (int task = gw; task < ntask; task += ngw) {
        const int cg = task % ncol, rg = task / ncol, pn = cg >> 2, wc = cg & 3;
        const bf16_t* ap = A + (size_t)(64 * rg + fr) * K + 8 * fq;
        const bf16_t* bp = Bt + (size_t)(256 * pn + 32 * wc + fr) * K + 8 * fq;
        f32x4 acc[4][2][2];
#pragma unroll
        for (int rs = 0; rs < 4; ++rs)
#pragma unroll
            for (int bj = 0; bj < 2; ++bj)
#pragma unroll
                for (int n = 0; n < 2; ++n) acc[rs][bj][n] = (f32x4){0.f, 0.f, 0.f, 0.f};
#pragma unroll 2
        for (int ks = 0; ks < K / 32; ++ks) {
            bf16x8 a[4], b[2][2];
#pragma unroll
            for (int rs = 0; rs < 4; ++rs) a[rs] = *(const bf16x8*)(ap + (size_t)(16 * rs) * K + 32 * ks);
#pragma unroll
            for (int bj = 0; bj < 2; ++bj)
#pragma unroll
                for (int n = 0; n < 2; ++n) b[bj][n] = *(const bf16x8*)(bp + (size_t)(128 * bj + 16 * n) * K + 32 * ks);
#pragma unroll
            for (int rs = 0; rs < 4; ++rs)
#pragma unroll
                for (int bj = 0; bj < 2; ++bj)
#pragma unroll
                    for (int n = 0; n < 2; ++n) acc[rs][bj][n] = __builtin_amdgcn_mfma_f32_16x16x32_bf16(b[bj][n], a[rs], acc[rs][bj][n], 0, 0, 0);
        }
#pragma unroll
        for (int rs = 0; rs < 4; ++rs) f.rowquad(64 * rg + 16 * rs + fr, 256 * pn, wc, fq, acc[rs][0][0], acc[rs][0][1], acc[rs][1][0], acc[rs][1][1]);
    }
}

constexpr size_t MiB = 1u << 20;
constexpr size_t WS_CTL = 0, CTL_ZERO_BYTES = 256 * 1024;
constexpr size_t WS_BND = 512 * 1024;
constexpr size_t WS_ROPE = 1 * MiB;
constexpr size_t WS_WAIN = 2 * MiB, WS_WUQ = 4 * MiB, WS_WUK = 6 * MiB, WS_WUV = 6 * MiB + 512 * 1024, WS_WAOUT = 8 * MiB;
constexpr size_t WS_WFIN0 = 10 * MiB, WS_WFIN1 = 21 * MiB, WS_WFOUT0 = 32 * MiB, WS_WFOUT1 = 38 * MiB, WS_WKVQ = 44 * MiB, WS_WBOUT = 47 * MiB;
constexpr size_t WS_HB = 50 * MiB;
constexpr size_t WS_AF = 84 * MiB;
constexpr size_t WS_CQ = 136 * MiB;
constexpr size_t WS_CKV = 150 * MiB;
constexpr size_t WS_KPE = 160 * MiB;
constexpr size_t WS_QRAW = 162 * MiB;
constexpr size_t WS_KNRAW = 214 * MiB;
constexpr size_t WS_VT = 248 * MiB;
constexpr size_t WS_QF = 282 * MiB;
constexpr size_t WS_KN = 334 * MiB;
constexpr size_t WS_O = 368 * MiB;
constexpr size_t WS_PART = 402 * MiB;
constexpr size_t WS_PARTL = 418 * MiB;
constexpr size_t WS_H1 = 420 * MiB;
constexpr size_t WS_H2 = 486 * MiB;
constexpr size_t WS_ACT = 552 * MiB;
constexpr size_t WS_KVF = 642 * MiB;
constexpr size_t WS_QBRAW = 676 * MiB;
constexpr size_t WS_VST = 710 * MiB;
constexpr size_t WS_KS = 720 * MiB;
constexpr size_t WS_VS = 730 * MiB;
constexpr size_t WS_QBF = 740 * MiB;
constexpr size_t WS_SS = 776 * MiB;
constexpr size_t WS_END = 778 * MiB;
constexpr int CW_BAR = 4096;

constexpr int RING_BYTES = 131072, MISC_OFF = 163584, LDS_BYTES = 163840;

struct Args { const void* in[28]; float* out; unsigned char* ws; int ph_lo, ph_hi, li, never, flags, pad; };

struct Ctx {
    LAS unsigned char* lds; int tid, lane, wave, gw, ngw; unsigned char* ws; float* out;
    const Args& a;
    __device__ __forceinline__ const float* x_prompt() const { return (const float*)a.in[0]; }
    __device__ __forceinline__ const float* x_sample() const { return (const float*)a.in[1]; }
    __device__ __forceinline__ const float* cache() const { return (const float*)a.in[2]; }
    __device__ __forceinline__ const float* swk() const { return (const float*)a.in[3]; }
    __device__ __forceinline__ const float* swv() const { return (const float*)a.in[4]; }
    __device__ __forceinline__ const int* page_table() const { return (const int*)a.in[5]; }
    __device__ __forceinline__ const float* norm_attn() const { return (const float*)a.in[6]; }
    __device__ __forceinline__ const float* norm_ffn() const { return (const float*)a.in[7]; }
    __device__ __forceinline__ const float* w_a_in() const { return (const float*)a.in[8]; }
    __device__ __forceinline__ const float* g_qc() const { return (const float*)a.in[9]; }
    __device__ __forceinline__ const float* w_uq() const { return (const float*)a.in[10]; }
    __device__ __forceinline__ const float* g_ckv() const { return (const float*)a.in[11]; }
    __device__ __forceinline__ const float* w_uk() const { return (const float*)a.in[12]; }
    __device__ __forceinline__ const float* w_uv() const { return (const float*)a.in[13]; }
    __device__ __forceinline__ const float* g_qn() const { return (const float*)a.in[14]; }
    __device__ __forceinline__ const float* g_qr() const { return (const float*)a.in[15]; }
    __device__ __forceinline__ const float* g_kn() const { return (const float*)a.in[16]; }
    __device__ __forceinline__ const float* g_kr() const { return (const float*)a.in[17]; }
    __device__ __forceinline__ const float* w_a_out() const { return (const float*)a.in[18]; }
    __device__ __forceinline__ const float* g_kv() const { return (const float*)a.in[19]; }
    __device__ __forceinline__ const float* w_kv() const { return (const float*)a.in[20]; }
    __device__ __forceinline__ const float* g_k_b() const { return (const float*)a.in[21]; }
    __device__ __forceinline__ const float* w_q_b() const { return (const float*)a.in[22]; }
    __device__ __forceinline__ const float* g_q_b() const { return (const float*)a.in[23]; }
    __device__ __forceinline__ const float* sinks() const { return (const float*)a.in[24]; }
    __device__ __forceinline__ const float* w_b_out() const { return (const float*)a.in[25]; }
    __device__ __forceinline__ const float* w_ffn_in() const { return (const float*)a.in[26]; }
    __device__ __forceinline__ const float* w_ffn_out() const { return (const float*)a.in[27]; }
    template <class Tp> __device__ __forceinline__ Tp* p(size_t off) const { return (Tp*)(ws + off); }
};

__device__ __forceinline__ void p0_item(const float* W, int ldw, int K, bf16_t* WT, int d0, int s0, const float* gain, int kb, LAS float* scr, int lane) {
    const int k0 = 64 * kb;
#pragma unroll
    for (int u = 0; u < 8; ++u) { const int idx = lane + 64 * u, kk = idx >> 3, n4 = (idx & 7) * 4;
        f32x4 v = {0.f, 0.f, 0.f, 0.f}; if (s0 >= 0) { v = *(const f32x4*)(W + (size_t)(k0 + kk) * ldw + s0 + n4); if (gain) v *= gain[k0 + kk]; }
        LAS float* d = scr + kk * 33 + n4; d[0] = v[0]; d[1] = v[1]; d[2] = v[2]; d[3] = v[3]; }
    asm volatile("s_waitcnt lgkmcnt(0)" ::: "memory");
    const int c = lane & 7;
#pragma unroll
    for (int j = 0; j < 4; ++j) { const int n = (lane >> 3) + 8 * j; const LAS float* s = scr + (8 * c) * 33 + n;
        u32x4 o; o.x = pk2(s[0 * 33], s[1 * 33]); o.y = pk2(s[2 * 33], s[3 * 33]); o.z = pk2(s[4 * 33], s[5 * 33]); o.w = pk2(s[6 * 33], s[7 * 33]);
        *(u32x4*)(WT + (size_t)(d0 + n) * K + k0 + 8 * c) = o; }
    asm volatile("s_waitcnt lgkmcnt(0)" ::: "memory");
}
__device__ __forceinline__ void p0_job(const Ctx& C, LAS float* scr, const float* W, int ldw, int K, int nd, bf16_t* WT, int drow0, const float* gain, int map, int nsrc, int& base) {
    const int nblk = nd / 32, nit = (K / 64) * nblk;
    int it0 = C.gw - (base % C.ngw); if (it0 < 0) it0 += C.ngw;
    for (int it = it0; it < nit; it += C.ngw) {
        const int kb = it / nblk, nb = it % nblk, d0 = 32 * nb;
        int s0 = d0;
        const int pn = d0 >> 8, c0 = d0 & 255, mbj = c0 >> 7, mwc = (c0 >> 5) & 3;
        if (map == 1) s0 = (c0 < 128) ? 128 * pn + c0 : 2816 + 128 * pn + (c0 - 128);
        else if (map == 2) s0 = (pn < 4) ? (4 * pn + mwc) * 96 + 32 * mbj : (8 * (pn - 4) + 4 * mbj + mwc) * 96 + 64;
        else if (map == 3) s0 = (4 * pn + mwc) * 64 + 32 * mbj;
        else if (map == 4) s0 = (pn == 0) ? mwc * 64 + 32 * mbj : d0;
        else if (map == 5) s0 = (d0 < 384) ? d0 : (d0 == 384 ? 640 : (d0 < 512 ? 1 << 20 : d0 - 128));
        if (s0 >= nsrc) s0 = -1;
        p0_item(W, ldw, K, WT, drow0 + d0, s0, gain, kb, scr, C.lane);
    }
    base += nit;
}
__device__ __forceinline__ void p0_prologue(const Ctx& C) {
    LAS float* scr = (LAS float*)(C.lds + C.wave * 16384);
    int base = 0;
    p0_job(C, scr, C.w_a_in(), 672, 1024, 768, C.p<bf16_t>(WS_WAIN), 0, C.norm_attn(), 5, 672, base);
    p0_job(C, scr, C.w_uq(), 1536, 384, 1536, C.p<bf16_t>(WS_WUQ), 0, nullptr, 2, 1536, base);
    p0_job(C, scr, C.w_uk(), 1024, 256, 1024, C.p<bf16_t>(WS_WUK), 0, nullptr, 3, 1024, base);
    p0_job(C, scr, C.w_uv(), 1024, 256, 1024, C.p<bf16_t>(WS_WUV), 0, nullptr, 0, 1024, base);
    p0_job(C, scr, C.w_a_out(), 1024, 1024, 1024, C.p<bf16_t>(WS_WAOUT), 0, nullptr, 0, 1024, base);
    p0_job(C, scr, C.w_ffn_in(), 5632, 1024, 5632, C.p<bf16_t>(WS_WFIN0), 0, C.norm_ffn(), 1, 5632, base);
    p0_job(C, scr, C.w_ffn_in() + (size_t)1024 * 5632, 5632, 1024, 5632, C.p<bf16_t>(WS_WFIN1), 0, C.norm_ffn() + 1024, 1, 5632, base);
    p0_job(C, scr, C.w_ffn_out(), 1024, 2816, 1024, C.p<bf16_t>(WS_WFOUT0), 0, nullptr, 0, 1024, base);
    p0_job(C, scr, C.w_ffn_out() + (size_t)2816 * 1024, 1024, 2816, 1024, C.p<bf16_t>(WS_WFOUT1), 0, nullptr, 0, 1024, base);
    p0_job(C, scr, C.w_kv(), 512, 1024, 512, C.p<bf16_t>(WS_WKVQ), 0, C.g_kv(), 4, 512, base);
    p0_job(C, scr, C.w_q_b(), 1024, 1024, 1024, C.p<bf16_t>(WS_WKVQ), 512, C.norm_attn() + 1024, 3, 1024, base);
    p0_job(C, scr, C.w_b_out(), 1024, 1024, 1024, C.p<bf16_t>(WS_WBOUT), 0, nullptr, 0, 1024, base);
    { float* cosA = C.p<float>(WS_ROPE); float* sinA = cosA + NPOS * 16; float* cosB = sinA + NPOS * 16; float* sinB = cosB + NPOS * 8;
      for (int i = C.gw * 64 + C.lane; i < NPOS * 16; i += C.ngw * 64) {
          const int p = i / 16, j = i % 16; const float pos = (float)(p < SEQ ? p : PAST + (p - SEQ));
          { const float inv = (float)pow(500000.0, -(double)(2 * j) / 32.0); const float ang = pos * inv; cosA[i] = (float)cos((double)ang); sinA[i] = (float)sin((double)ang); }
          if (j < 8) { const float inv = (float)pow(500000.0, -(double)(2 * j) / 16.0); const float ang = pos * inv; cosB[p * 8 + j] = (float)cos((double)ang); sinB[p * 8 + j] = (float)sin((double)ang); }
      } }
    { float* ssz = C.p<float>(WS_SS); for (int i = C.gw * 64 + C.lane; i < 5 * T; i += C.ngw * 64) ssz[i] = 0.f; }
    { float* out_wks = C.out + (size_t)T * DM + (size_t)T * DCKV + (size_t)2 * NB * WIN * 256; float* out_wvs = out_wks + (size_t)DB * WIN * 256;
      for (size_t i = (size_t)C.gw * 64 + C.lane; i < (size_t)DB * (WIN - DS) * 256; i += (size_t)C.ngw * 64) { const size_t b = i / ((WIN - DS) * 256), r = i % ((WIN - DS) * 256);
          out_wks[b * WIN * 256 + r] = C.swk()[b * WIN * 256 + DS * 256 + r]; out_wvs[b * WIN * 256 + r] = C.swv()[b * WIN * 256 + DS * 256 + r]; } }
    if (C.gw == 0) {
        float a = fabsf(C.g_qn()[C.lane]), b = fabsf(C.g_kn()[C.lane]), c = C.lane < 32 ? fabsf(C.g_qr()[C.lane]) : 0.f, d = C.lane < 32 ? fabsf(C.g_kr()[C.lane]) : 0.f;
        float e = fabsf(C.g_q_b()[C.lane]), f = fabsf(C.g_k_b()[C.lane]), s = C.lane < 16 ? C.sinks()[C.lane] : -1e30f;
#pragma unroll
        for (int o = 1; o < 64; o <<= 1) { a = fmaxf(a, __shfl_xor(a, o)); b = fmaxf(b, __shfl_xor(b, o)); c = fmaxf(c, __shfl_xor(c, o)); d = fmaxf(d, __shfl_xor(d, o));
            e = fmaxf(e, __shfl_xor(e, o)); f = fmaxf(f, __shfl_xor(f, o)); s = fmaxf(s, __shfl_xor(s, o)); }
        if (C.lane == 0) { float* bnd = C.p<float>(WS_BND); bnd[0] = SCALE_A * LOG2E * (64.f * a * b + 32.f * c * d) * 1.02f; bnd[1] = fmaxf(SCALE_B * LOG2E * 64.f * e * f * 1.02f, s * LOG2E); }
    }
}
__device__ __forceinline__ void norm_row_bf16(const float* xrow, bf16_t* orow, int lane) {
    const f32x4* xr = (const f32x4*)xrow + lane; f32x4 v[4]; float s = 0.f;
#pragma unroll
    for (int j = 0; j < 4; ++j) { v[j] = xr[64 * j]; s += (v[j].x * v[j].x + v[j].y * v[j].y) + (v[j].z * v[j].z + v[j].w * v[j].w); }
    const float r = rsqrtf(wave_sum(s) * (1.f / DM) + EPS);
    u32x2* o = (u32x2*)orow + lane;
#pragma unroll
    for (int j = 0; j < 4; ++j) o[64 * j] = (u32x2){pk2(v[j].x * r, v[j].y * r), pk2(v[j].z * r, v[j].w * r)};
}
__device__ __forceinline__ void p_norm_x(const Ctx& C) {
    bf16_t* hb = C.p<bf16_t>(WS_HB);
    for (int t = C.gw; t < T; t += C.ngw) norm_row_bf16(t < TP ? C.x_prompt() + (size_t)t * DM : C.x_sample() + (size_t)(t - TP) * DM, hb + (size_t)t * DM, C.lane);
}
__device__ __forceinline__ void p_norm_h(const Ctx& C, const float* H) {
    bf16_t* hb = C.p<bf16_t>(WS_HB);
    for (int t = C.gw; t < T; t += C.ngw) norm_row_bf16(H + (size_t)t * DM, hb + (size_t)t * DM, C.lane);
}
__device__ __forceinline__ void p_rows_out(const Ctx& C) {
    const bf16_t* CKV = C.p<bf16_t>(WS_CKV); const float* sskv = C.p<float>(WS_SS) + 4 * T; float* ROWS = C.out + (size_t)T * DM; const int lane = lane_id_fresh();
    for (int t0 = 4 * C.gw; t0 < T; t0 += 4 * C.ngw) {
        u32x2 w[4]; float r[4];
#pragma unroll
        for (int i = 0; i < 4; ++i) { w[i] = *(const u32x2*)(CKV + (size_t)(t0 + i) * DC + 4 * lane); r[i] = sskv[t0 + i]; }
#pragma unroll
        for (int i = 0; i < 4; ++i) { const float rr = rsqrtf(r[i] * (1.f / DC) + EPS);
            *(f32x4*)(ROWS + (size_t)(t0 + i) * DCKV + 4 * lane) = (f32x4){bflo(w[i].x), bfhi(w[i].x), bflo(w[i].y), bfhi(w[i].y)} * rr; }
    }
}
__device__ __forceinline__ void p_post_a(const Ctx& C) {
    const float* AF = C.p<float>(WS_AF); bf16_t* CQ = C.p<bf16_t>(WS_CQ); bf16_t* CKV = C.p<bf16_t>(WS_CKV); bf16_t* KPE = C.p<bf16_t>(WS_KPE);
    float* ROWS = C.out + (size_t)T * DM; const float* cosA = C.p<float>(WS_ROPE); const float* sinA = cosA + NPOS * 16; const int lane = C.lane;
    for (int t = C.gw; t < T; t += C.ngw) {
        const float* a = AF + (size_t)t * 768;
        float q[6]; float s = 0.f;
#pragma unroll
        for (int i = 0; i < 6; ++i) { q[i] = a[lane + 64 * i]; s += q[i] * q[i]; }
        float r = rsqrtf(wave_sum(s) * (1.f / DQC) + EPS);
#pragma unroll
        for (int i = 0; i < 6; ++i) CQ[(size_t)t * DQC + lane + 64 * i] = (bf16_t)f2bf(q[i] * r * C.g_qc()[lane + 64 * i]);
        float k[4]; s = 0.f;
#pragma unroll
        for (int i = 0; i < 4; ++i) { k[i] = a[DQC + lane + 64 * i]; s += k[i] * k[i]; }
        r = rsqrtf(wave_sum(s) * (1.f / DC) + EPS);
#pragma unroll
        for (int i = 0; i < 4; ++i) { const float v = k[i] * r * C.g_ckv()[lane + 64 * i]; ROWS[(size_t)t * DCKV + lane + 64 * i] = v; CKV[(size_t)t * DC + lane + 64 * i] = (bf16_t)f2bf(v); }
        const float v = lane < 32 ? a[DQC + DC + lane] : 0.f;
        r = rsqrtf(wave_sum(v * v) * (1.f / 32) + EPS);
        const float vn = lane < 32 ? v * r * C.g_kr()[lane] : 0.f, other = __shfl_xor(vn, 16);
        const int p = tok_pidx(t), j = lane & 15; const float c = cosA[p * 16 + j], sn = sinA[p * 16 + j];
        const float o = (lane < 16) ? (vn * c - other * sn) : (vn * c + other * sn);
        if (lane < 32) { ROWS[(size_t)t * DCKV + DC + lane] = o; KPE[(size_t)t * 32 + lane] = (bf16_t)f2bf(o); }
    }
}
}
namespace mk {
__device__ __forceinline__ bf16x8 pack8(float a0, float a1, float a2, float a3, float a4, float a5, float a6, float a7) {
    u32x4 w = {pk2(a0, a1), pk2(a2, a3), pk2(a4, a5), pk2(a6, a7)}; return __builtin_bit_cast(bf16x8, w); }
#define MFMA32(a, b, c) __builtin_amdgcn_mfma_f32_32x32x16_bf16((a), (b), (c), 0, 0, 0)
__device__ __forceinline__ f32x16 zero16() { f32x16 z;
#pragma unroll
    for (int i = 0; i < 16; ++i) z[i] = 0.f; return z; }

constexpr int AT_KP = 208, AT_VP = 192, AT_KBYTES = 64 * AT_KP, AT_VBYTES = 64 * AT_VP, AT_BUF = AT_KBYTES + AT_VBYTES;
typedef short v4i16_t __attribute__((ext_vector_type(4)));
__device__ __forceinline__ void mla_attn_unit(const Ctx& C, int b, int h, int qb, float bnd) {
    const int tid = C.tid, lane = C.lane, w = C.wave, l31 = lane & 31, hh = lane >> 5;
    const bf16_t* QF = C.p<bf16_t>(WS_QF); const bf16_t* KN = C.p<bf16_t>(WS_KN); const bf16_t* KPE = C.p<bf16_t>(WS_KPE); const bf16_t* KNV = C.p<bf16_t>(WS_KNRAW); bf16_t* O = C.p<bf16_t>(WS_O);
    const size_t tokq = (size_t)b * SEQ + qb * 256 + 32 * w + l31;
    bf16x8 qf[6];
    { const bf16_t* qp = QF + (tokq * 16 + h) * 96 + 8 * hh;
#pragma unroll
      for (int s = 0; s < 6; ++s) qf[s] = *(const bf16x8*)(qp + 16 * s); }
    f32x16 oT[2]; oT[0] = zero16(); oT[1] = zero16(); float lsum = 0.f;
    f32x16 negb;
#pragma unroll
    for (int i = 0; i < 16; ++i) negb[i] = -bnd;
    const int ntile = 4 * (qb + 1), mylast = 4 * qb + (w >> 1);
    const bf16_t* gK = KN + ((size_t)b * SEQ + (tid >> 3)) * 1024 + h * 64 + (tid & 7) * 8;
    const bf16_t* gR = KPE + ((size_t)b * SEQ + ((tid & 255) >> 2)) * 32 + (tid & 3) * 8;
    const bf16_t* gV = KNV + ((size_t)b * SEQ + (tid >> 3)) * 2048 + 1024 + h * 64 + (tid & 7) * 8;
    const unsigned sK = (tid >> 3) * AT_KP + (tid & 7) * 16, sR = ((tid & 255) >> 2) * AT_KP + 128 + (tid & 3) * 16, sV = AT_KBYTES + (tid >> 3) * AT_VP + (tid & 7) * 16;
    u32x4 rkA, rrA = {0u, 0u, 0u, 0u}, rvA, rkB, rrB = {0u, 0u, 0u, 0u}, rvB;
#define AT_LOAD(K_, R_, V_, t_) do { K_ = *(const u32x4*)(gK + (size_t)(t_) * 64 * 1024); if (tid < 256) R_ = *(const u32x4*)(gR + (size_t)(t_) * 64 * 32); V_ = *(const u32x4*)(gV + (size_t)(t_) * 64 * 2048); } while (0)
#define AT_STORE(K_, R_, V_, b_) do { LAS unsigned char* d_ = C.lds + (b_) * AT_BUF; *(LAS u32x4*)(d_ + sK) = K_; if (tid < 256) *(LAS u32x4*)(d_ + sR) = R_; *(LAS u32x4*)(d_ + sV) = V_; } while (0)
    AT_LOAD(rkA, rrA, rvA, 0);
    if (ntile > 1) AT_LOAD(rkB, rrB, rvB, 1);
    AT_STORE(rkA, rrA, rvA, 0);
    __syncthreads();
    const int tr_off = (4 * hh + ((lane & 15) >> 2)) * AT_VP + (16 * ((lane >> 4) & 1) + 4 * (lane & 3)) * 2;
    int cur = 0;
    const bool grpB = w >= 4;
#define AT_STEP(LK_, LR_, LV_, SK_, SR_, SV_) do { const int nb1 = cur == 2 ? 0 : cur + 1; \
        if (jt + 2 < ntile) AT_LOAD(LK_, LR_, LV_, jt + 2); \
        at_S(jt); \
        if (grpB) { if (jt + 1 < ntile) AT_STORE(SK_, SR_, SV_, nb1); __syncthreads(); } \
        __builtin_amdgcn_s_setprio(2); at_PV(jt); __builtin_amdgcn_s_setprio(0); \
        if (!grpB) { if (jt + 1 < ntile) AT_STORE(SK_, SR_, SV_, nb1); __syncthreads(); } \
        cur = nb1; ++jt; } while (0)
    f32x16 p0, p1;
    auto at_S = [&](int jt) __attribute__((always_inline)) {
        if (jt <= mylast) {
            const LAS unsigned char* kb = C.lds + cur * AT_BUF + l31 * AT_KP + hh * 16;
            p0 = negb; p1 = negb;
#pragma unroll
            for (int s = 0; s < 6; ++s) { const bf16x8 a0 = *(const LAS bf16x8*)(kb + s * 32), a1 = *(const LAS bf16x8*)(kb + 32 * AT_KP + s * 32);
                p0 = MFMA32(a0, qf[s], p0); p1 = MFMA32(a1, qf[s], p1); }
        }
    };
    auto at_PV = [&](int jt) __attribute__((always_inline)) {
        if (jt <= mylast) {
            const bool diag = (jt == mylast); const int qrel = 32 * (w & 1) + l31;
            float e0[16], e1[16];
#pragma unroll
            for (int r = 0; r < 16; ++r) { const int kk = (r & 3) + 8 * (r >> 2) + 4 * hh;
                e0[r] = __builtin_amdgcn_exp2f(p0[r]); e1[r] = __builtin_amdgcn_exp2f(p1[r]);
                if (diag) { if (kk > qrel) e0[r] = 0.f; if (kk + 32 > qrel) e1[r] = 0.f; }
                lsum += e0[r] + e1[r]; }
            bf16x8 pb[2][2];
            pb[0][0] = pack8(e0[0], e0[1], e0[2], e0[3], e0[4], e0[5], e0[6], e0[7]); pb[0][1] = pack8(e0[8], e0[9], e0[10], e0[11], e0[12], e0[13], e0[14], e0[15]);
            pb[1][0] = pack8(e1[0], e1[1], e1[2], e1[3], e1[4], e1[5], e1[6], e1[7]); pb[1][1] = pack8(e1[8], e1[9], e1[10], e1[11], e1[12], e1[13], e1[14], e1[15]);
            const LAS unsigned char* vb = C.lds + cur * AT_BUF + AT_KBYTES + tr_off;
#pragma unroll
            for (int dt = 0; dt < 2; ++dt)
#pragma unroll
                for (int kh = 0; kh < 2; ++kh)
#pragma unroll
                    for (int ks = 0; ks < 2; ++ks) { const LAS unsigned char* ad = vb + (32 * kh + 16 * ks) * AT_VP + dt * 64;
                        const v4i16_t lo = __builtin_amdgcn_ds_read_tr16_b64_v4i16((LAS v4i16_t*)ad), hi = __builtin_amdgcn_ds_read_tr16_b64_v4i16((LAS v4i16_t*)(ad + 8 * AT_VP));
                        const bf16x8 av = {lo[0], lo[1], lo[2], lo[3], hi[0], hi[1], hi[2], hi[3]};
                        oT[dt] = MFMA32(av, pb[kh][ks], oT[dt]); }
        }
    };
    for (int jt = 0; jt < ntile;) {
        AT_STEP(rkA, rrA, rvA, rkB, rrB, rvB);
        AT_STEP(rkB, rrB, rvB, rkA, rrA, rvA);
    }
#undef AT_STEP
#undef AT_LOAD
#undef AT_STORE
    __syncthreads();
    lsum += __shfl_xor(lsum, 32); const float inv = 1.f / lsum;
    bf16_t* op = O + tokq * 1024 + h * 64 + 4 * hh;
#pragma unroll
    for (int dt = 0; dt < 2; ++dt)
#pragma unroll
        for (int g = 0; g < 4; ++g) *(u32x2*)(op + 32 * dt + 8 * g) = (u32x2){pk2(oT[dt][4 * g] * inv, oT[dt][4 * g + 1] * inv), pk2(oT[dt][4 * g + 2] * inv, oT[dt][4 * g + 3] * inv)};
}
__device__ __forceinline__ void p_mla_attn_prompt(const Ctx& C) {
    const float bnd = C.p<float>(WS_BND)[0];
    for (int u = blockIdx.x; u < NB * HA * 4; u += gridDim.x) {
        const int j = u & 3, h = (u >> 2) & 15, b = u >> 6;
        mla_attn_unit(C, b, h, 7 - j, bnd);
        mla_attn_unit(C, b, h, j, bnd);
    }
}

constexpr int SW_KP = 144, SW_VP = 192, SW_KBYTES = 256 * SW_KP;
struct SwaRegs { u32x4 k[4], v[4]; };
__device__ __forceinline__ void swa_load(const Ctx& C, int u, SwaRegs& R) {
    const int blk = u & 15, kvh = (u >> 4) & 3, b = u >> 6, tid = C.tid, kpos0 = 128 * (blk - 1);
    const bf16_t* KS = C.p<bf16_t>(WS_KS); const bf16_t* VSB = C.p<bf16_t>(WS_VS);
#pragma unroll
    for (int q = 0; q < 4; ++q) { const int i = tid + 512 * q, key = i >> 3, c = i & 7; const u32x4 z = {0u, 0u, 0u, 0u}; R.k[q] = z; R.v[q] = z;
        if (kpos0 + key >= 0) { const size_t o = ((size_t)b * SEQ + kpos0 + key) * 256 + kvh * 64 + c * 8; R.k[q] = *(const u32x4*)(KS + o); R.v[q] = *(const u32x4*)(VSB + o); } }
}
__device__ __forceinline__ void swa_store(const Ctx& C, const SwaRegs& R) {
    const int tid = C.tid;
#pragma unroll
    for (int q = 0; q < 4; ++q) { const int i = tid + 512 * q, key = i >> 3, c = i & 7;
        *(LAS u32x4*)(C.lds + key * SW_KP + c * 16) = R.k[q]; *(LAS u32x4*)(C.lds + SW_KBYTES + key * SW_VP + c * 16) = R.v[q]; }
}
__device__ __forceinline__ void swa_compute(const Ctx& C, int u, float bnd) {
    const int blk = u & 15, kvh = (u >> 4) & 3, b = u >> 6;
    const int lane = C.lane, w = C.wave, l31 = lane & 31, hh = lane >> 5;
    const bf16_t* QF = C.p<bf16_t>(WS_QBF); bf16_t* O = C.p<bf16_t>(WS_O);
    const int g = w >> 1, qh = w & 1, head = 4 * kvh + g;
    const float sk = __builtin_amdgcn_exp2f(C.sinks()[head] * LOG2E - bnd);
#pragma unroll 1
    for (int rg = 0; rg < 2; ++rg) {
        const int qr0 = 64 * qh + 32 * rg + l31; const size_t tok = (size_t)b * SEQ + 128 * blk + qr0;
        bf16x8 qf[4];
#pragma unroll
        for (int s = 0; s < 4; ++s) qf[s] = *(const bf16x8*)(QF + tok * 1024 + head * 64 + 16 * s + 8 * hh);
        f32x16 oT[2]; oT[0] = zero16(); oT[1] = zero16(); float lsum = 0.f;
        int kt0 = qh ? 1 : 0; const int kt1 = qh ? 3 : 2; if (blk == 0 && kt0 < 2) kt0 = 2;
#pragma unroll 1
        for (int kt = kt0; kt <= kt1; ++kt) {
            const LAS unsigned char* kb = C.lds + (64 * kt + l31) * SW_KP + hh * 16;
            f32x16 p0 = zero16(), p1 = zero16();
#pragma unroll
            for (int s = 0; s < 4; ++s) { const bf16x8 a0 = *(const LAS bf16x8*)(kb + s * 32), a1 = *(const LAS bf16x8*)(kb + 32 * SW_KP + s * 32);
                p0 = MFMA32(a0, qf[s], p0); p1 = MFMA32(a1, qf[s], p1); }
            float e0[16], e1[16];
#pragma unroll
            for (int r = 0; r < 16; ++r) { const int kk = 64 * kt + (r & 3) + 8 * (r >> 2) + 4 * hh;
                e0[r] = (kk > qr0 && kk <= qr0 + 128) ? __builtin_amdgcn_exp2f(p0[r] - bnd) : 0.f;
                e1[r] = (kk + 32 > qr0 && kk + 32 <= qr0 + 128) ? __builtin_amdgcn_exp2f(p1[r] - bnd) : 0.f;
                lsum += e0[r] + e1[r]; }
            bf16x8 pb[2][2];
            pb[0][0] = pack8(e0[0], e0[1], e0[2], e0[3], e0[4], e0[5], e0[6], e0[7]); pb[0][1] = pack8(e0[8], e0[9], e0[10], e0[11], e0[12], e0[13], e0[14], e0[15]);
            pb[1][0] = pack8(e1[0], e1[1], e1[2], e1[3], e1[4], e1[5], e1[6], e1[7]); pb[1][1] = pack8(e1[8], e1[9], e1[10], e1[11], e1[12], e1[13], e1[14], e1[15]);
            const LAS unsigned char* vb = C.lds + SW_KBYTES + (64 * kt + 4 * hh + ((lane & 15) >> 2)) * SW_VP + (16 * ((lane >> 4) & 1) + 4 * (lane & 3)) * 2;
#pragma unroll
            for (int dt = 0; dt < 2; ++dt)
#pragma unroll
                for (int kh = 0; kh < 2; ++kh)
#pragma unroll
                    for (int ks = 0; ks < 2; ++ks) { const LAS unsigned char* ad = vb + (32 * kh + 16 * ks) * SW_VP + dt * 64;
                        const v4i16_t lo = __builtin_amdgcn_ds_read_tr16_b64_v4i16((LAS v4i16_t*)ad), hi = __builtin_amdgcn_ds_read_tr16_b64_v4i16((LAS v4i16_t*)(ad + 8 * SW_VP));
                        const bf16x8 av = {lo[0], lo[1], lo[2], lo[3], hi[0], hi[1], hi[2], hi[3]};
                        oT[dt] = MFMA32(av, pb[kh][ks], oT[dt]); }
        }
        lsum += __shfl_xor(lsum, 32); const float inv = 1.f / (lsum + sk);
        bf16_t* op = O + tok * 1024 + head * 64 + 4 * hh;
#pragma unroll
        for (int dt = 0; dt < 2; ++dt)
#pragma unroll
            for (int gg = 0; gg < 4; ++gg) *(u32x2*)(op + 32 * dt + 8 * gg) = (u32x2){pk2(oT[dt][4 * gg] * inv, oT[dt][4 * gg + 1] * inv), pk2(oT[dt][4 * gg + 2] * inv, oT[dt][4 * gg + 3] * inv)};
    }
}
constexpr int SS_KP = 65, SS_K = 0, SS_V = 132 * SS_KP * 4, SS_Q = SS_V + 132 * 64 * 4, SS_P = SS_Q + 16 * 64 * 4;
__device__ __forceinline__ void swa_sample(const Ctx& C, float bnd) {
    const bf16_t* QF = C.p<bf16_t>(WS_QBF); const bf16_t* KS = C.p<bf16_t>(WS_KS); const bf16_t* VS = C.p<bf16_t>(WS_VS); bf16_t* O = C.p<bf16_t>(WS_O);
    const int lane = C.lane, tid = C.tid, w = C.wave;
    LAS float* Kl = (LAS float*)(C.lds + SS_K); LAS float* Vl = (LAS float*)(C.lds + SS_V); LAS float* Ql = (LAS float*)(C.lds + SS_Q); LAS float* Pl = (LAS float*)(C.lds + SS_P) + w * 192;
    for (int u = blockIdx.x; u < DB * NKV; u += gridDim.x) {
        const int b = u >> 2, kvh = u & 3;
#pragma unroll
        for (int k = 0; k < 4; ++k) { const int i = tid + 512 * k, row = i >> 4, c = (i & 15) * 4;
            const f32x4 kv = *(const f32x4*)(C.swk() + ((size_t)(b * WIN + row) * NKV + kvh) * 64 + c), vv = *(const f32x4*)(C.swv() + ((size_t)(b * WIN + row) * NKV + kvh) * 64 + c);
            Kl[row * SS_KP + c] = kv[0]; Kl[row * SS_KP + c + 1] = kv[1]; Kl[row * SS_KP + c + 2] = kv[2]; Kl[row * SS_KP + c + 3] = kv[3];
            *(LAS f32x4*)(Vl + row * 64 + c) = vv; }
        if (tid < 256) { const int j = tid >> 6, i = tid & 63; const size_t src = ((size_t)(TP + b * DS + j) * NKV + kvh) * 64 + i;
            Kl[(128 + j) * SS_KP + i] = bf2f(KS[src]); Vl[(128 + j) * 64 + i] = bf2f(VS[src]); }
#pragma unroll
        for (int k = 0; k < 2; ++k) { const int i = tid + 512 * k, r = i >> 6, dd = i & 63, g = r >> 2, tt = r & 3;
            Ql[i] = bf2f(QF[(size_t)(TP + b * DS + tt) * 1024 + (4 * kvh + g) * 64 + dd]); }
        __syncthreads();
#pragma unroll 1
        for (int rr = 0; rr < 2; ++rr) {
            const int r = 2 * w + rr, g = r >> 2, tt = r & 3, h = 4 * kvh + g;
            const LAS float* q = Ql + r * 64;
            float l = 0.f;
#pragma unroll
            for (int k = 0; k < 3; ++k) { const int j = lane + 64 * k; float p = 0.f;
                const bool ok = (j < 128) ? (j >= tt + 1) : (j - 128 <= tt);
                if (j < 132 && ok) { const LAS float* kp = Kl + j * SS_KP; float dsum = 0.f;
#pragma unroll 16
                    for (int i = 0; i < 64; ++i) dsum += q[i] * kp[i];
                    p = __builtin_amdgcn_exp2f(dsum - bnd); }
                Pl[j] = p; l += p; }
            l = wave_sum(l) + __builtin_amdgcn_exp2f(C.sinks()[h] * LOG2E - bnd);
            asm volatile("s_waitcnt lgkmcnt(0)" ::: "memory");
            float acc = 0.f;
#pragma unroll 4
            for (int j = 0; j < 132; ++j) acc += Pl[j] * Vl[j * 64 + lane];
            O[(size_t)(TP + b * DS + tt) * 1024 + h * 64 + lane] = (bf16_t)f2bf(acc / l);
            asm volatile("s_waitcnt lgkmcnt(0)" ::: "memory");
        }
        __syncthreads();
    }
}
__device__ __forceinline__ void p_swa_attn(const Ctx& C) {
    const float bnd = C.p<float>(WS_BND)[1];
    { SwaRegs R; int u = blockIdx.x; const int nu = NB * NKV * 16;
      if (u < nu) { swa_load(C, u, R); swa_store(C, R); }
      __syncthreads();
      for (; u < nu; u += gridDim.x) { const int un = u + gridDim.x;
          if (un < nu) swa_load(C, un, R);
          swa_compute(C, u, bnd);
          __syncthreads();
          if (un < nu) swa_store(C, R);
          __syncthreads(); } }
    swa_sample(C, bnd);
}

constexpr int DC_CP = 528;
constexpr int DC_CIMG = 0, DC_CIMG_BYTES = 32 * DC_CP, DC_KPE_BYTES = 32 * 80, DC_IMG = DC_CIMG_BYTES + DC_KPE_BYTES, DC_KPE = DC_CIMG + DC_CIMG_BYTES;
constexpr int DC_PP = 80, DC_PIMG = DC_CIMG + 4 * DC_IMG, DC_PIMG_BYTES = 32 * DC_PP, DC_QC = DC_PIMG + 3 * DC_PIMG_BYTES, DC_PTAB = DC_QC + 8 * 6 * 2 * 4 * 16, DC_END = DC_PTAB + 128;
static_assert(DC_END <= MISC_OFF, "decode LDS map");
constexpr int DC_NSTEP = 128;
__device__ __forceinline__ int dec_cu_of(int pairIdx, int half) { return (pairIdx & 7) | (half << 3) | ((pairIdx >> 3) << 4); }
#define DC_BAR() asm volatile("s_waitcnt lgkmcnt(0)\n\ts_barrier" ::: "memory")
__device__ __forceinline__ void dec_A(const bf16x8 (&a)[2][16], bf16x8 (&bq)[4], const LAS unsigned char* cimg, int lane, f32x16& k0, f32x16& k1) {
    const LAS unsigned char* cb = cimg + (lane & 31) * DC_CP + (lane >> 5) * 16;
    k0 = zero16(); k1 = zero16();
#pragma unroll
    for (int s = 0; s < 16; ++s) {
        k0 = MFMA32(a[0][s], bq[s & 3], k0); k1 = MFMA32(a[1][s], bq[s & 3], k1);
        if (s + 4 < 16) bq[s & 3] = *(const LAS bf16x8*)(cb + (s + 4) * 32);
    }
}
__device__ __forceinline__ void dec_H2(const Ctx& C, const f32x16& k0, const f32x16& k1, const LAS unsigned char* kpe, LAS unsigned char* pimg, int w, int lane, float bnd) {
    const int l31 = lane & 31, hh = lane >> 5;
    const LAS unsigned char* qcb = C.lds + DC_QC + ((w * 12 + hh) * 4 + (l31 & 3)) * 16;
    const LAS unsigned char* kpb = kpe + l31 * 80 + hh * 16;
    typedef float f32x2_t __attribute__((ext_vector_type(2)));
    f32x2_t s0 = {0.f, 0.f}, s1 = {0.f, 0.f}, s2 = {0.f, 0.f}, s3 = {0.f, 0.f};
#pragma unroll
    for (int r = 0; r < 16; r += 4) {
        const f32x2_t a0 = {k0[r], k0[r + 1]}, a1 = {k0[r + 2], k0[r + 3]}, b0 = {k1[r], k1[r + 1]}, b1 = {k1[r + 2], k1[r + 3]};
        s0 = a0 * a0 + s0; s1 = a1 * a1 + s1; s2 = b0 * b0 + s2; s3 = b1 * b1 + s3; }
    const f32x2_t st = (s0 + s1) + (s2 + s3);
    float ss = st[0] + st[1];
    ss += __builtin_bit_cast(float, __builtin_amdgcn_ds_bpermute((lane ^ 32) << 2, __builtin_bit_cast(int, ss)));
    const float m = ss * (1.f / 64) + EPS, rn = rsqrtf(m), irn = m * rn;
    bf16x8 X[4];
    X[0] = pack8(k0[0], k0[1], k0[2], k0[3], k0[4], k0[5], k0[6], k0[7]); X[1] = pack8(k0[8], k0[9], k0[10], k0[11], k0[12], k0[13], k0[14], k0[15]);
    X[2] = pack8(k1[0], k1[1], k1[2], k1[3], k1[4], k1[5], k1[6], k1[7]); X[3] = pack8(k1[8], k1[9], k1[10], k1[11], k1[12], k1[13], k1[14], k1[15]);
    f32x16 S = zero16();
#pragma unroll
    for (int s = 4; s < 6; ++s) S = MFMA32(*(const LAS bf16x8*)(qcb + s * 128), *(const LAS bf16x8*)(kpb + (s - 4) * 32), S);
#pragma unroll
    for (int t = 0; t < 4; ++t) S[t] *= irn;
#pragma unroll
    for (int s = 0; s < 4; ++s) S = MFMA32(*(const LAS bf16x8*)(qcb + s * 128), X[s], S);
    if (lane < 32) {
        const unsigned p01 = pk2(__builtin_amdgcn_exp2f(S[0] * rn - bnd), __builtin_amdgcn_exp2f(S[1] * rn - bnd)), p23 = pk2(__builtin_amdgcn_exp2f(S[2] * rn - bnd), __builtin_amdgcn_exp2f(S[3] * rn - bnd));
        LAS bf16_t* pp = (LAS bf16_t*)(pimg + (4 * w) * DC_PP + lane * 2);
        pp[0] = (bf16_t)(p01 & 0xffffu); pp[DC_PP / 2] = (bf16_t)(p01 >> 16); pp[2 * (DC_PP / 2)] = (bf16_t)(p23 & 0xffffu); pp[3 * (DC_PP / 2)] = (bf16_t)(p23 >> 16);
    }
}
__device__ __forceinline__ const f32x4* dec_src(const Ctx& C, int s, int tid) {
    const int page = __builtin_amdgcn_readfirstlane(*(const LAS int*)(C.lds + DC_PTAB + (s >> 2) * 4));
    return (const f32x4*)(C.cache() + ((size_t)page * PAGE + 32 * (s & 3)) * DCKV) + tid;
}
__device__ __forceinline__ const f32x4* dec_src_pg(const Ctx& C, int pg, int s, int tid) {
    const int page = __builtin_amdgcn_readfirstlane(pg);
    return (const f32x4*)(C.cache() + ((size_t)page * PAGE + 32 * (s & 3)) * DCKV) + tid;
}
#define DEC_LOAD(v, src, w) do { v[0] = (src)[0]; v[1] = (src)[512]; v[2] = (src)[1024]; v[3] = (src)[1536]; if ((w) < 4) v[4] = (src)[2048]; asm volatile("" ::: "memory"); } while (0)
__device__ __forceinline__ void dec_put(const f32x4 (&v)[5], LAS unsigned char* img, int w, const int (&po)[5]) {
#pragma unroll
    for (int u = 0; u < 5; ++u) {
        if (u < 4 || w < 4) {
            const u32x2 o = {pk2(v[u][0], v[u][1]), pk2(v[u][2], v[u][3])};
            *(LAS u32x2*)(img + po[u]) = o; }
    }
}
__device__ __forceinline__ void p_mla_decode(const Ctx& C) {
    const int tid = C.tid, lane = C.lane, w = C.wave, l31 = lane & 31, hh = lane >> 5;
    const int cu = blockIdx.x; if (cu >= 256) return;
    const int half = (cu >> 3) & 1, pairIdx = (cu & 7) | ((cu >> 4) << 3), b = pairIdx >> 2, pgbase = (pairIdx & 3) * 32, h = 8 * half + w;
    const float bnd = C.p<float>(WS_BND)[0];
    const bf16_t* QF = C.p<bf16_t>(WS_QF); const bf16_t* WUKT = C.p<bf16_t>(WS_WUK);
    const int* ptab = C.page_table() + b * NPAGES + pgbase;
    const int key0 = tid / 72, c0 = tid % 72;
    int po[5];
    { int key = key0, c4 = c0;
#pragma unroll
      for (int u = 0; u < 5; ++u) { po[u] = c4 < 64 ? key * DC_CP + c4 * 8 : DC_CIMG_BYTES + key * 80 + (c4 - 64) * 8; c4 += 8; key += 7; if (c4 >= 72) { c4 -= 72; key += 1; } } }
    if (tid < 32) *(LAS int*)(C.lds + DC_PTAB + tid * 4) = ptab[tid];
    __syncthreads();
    const bool grpB = w >= 4;
    f32x4 v[5];
    { const f32x4* src = dec_src(C, 0, tid); DEC_LOAD(v, src, w); }
    for (int idx = tid; idx < 8 * 6 * 2 * 4; idx += NTHR) {
        const int t = idx & 3, h2 = (idx >> 2) & 1, s = (idx >> 3) % 6, hl = idx / 48;
        const bf16_t* q = QF + ((size_t)(TP + b * DS + t) * 16 + 8 * half + hl) * 96; float qv[8];
#pragma unroll
        for (int j = 0; j < 8; ++j) { if (s < 4) { const int dim = 16 * s + 8 * (j >> 2) + 4 * h2 + (j & 3); qv[j] = bf2f(q[dim]) * C.g_kn()[dim]; } else qv[j] = bf2f(q[64 + 16 * (s - 4) + 8 * h2 + j]); }
        *(LAS bf16x8*)(C.lds + DC_QC + idx * 16) = pack8(qv[0], qv[1], qv[2], qv[3], qv[4], qv[5], qv[6], qv[7]);
    }
    for (int i = tid; i < 2 * DC_IMG / 16; i += NTHR) *(LAS u32x4*)(C.lds + DC_CIMG + 2 * DC_IMG + i * 16) = (u32x4){0u, 0u, 0u, 0u};
    for (int i = tid; i < 2 * DC_PIMG_BYTES / 4; i += NTHR) *(LAS unsigned*)(C.lds + DC_PIMG + DC_PIMG_BYTES + i * 4) = 0u;
    dec_put(v, C.lds + DC_CIMG, w, po);
    { const f32x4* src = dec_src(C, 1, tid); DEC_LOAD(v, src, w); }
    if (grpB) {
        dec_put(v, C.lds + DC_CIMG + DC_IMG, w, po);
        asm volatile("" ::: "memory");
        const f32x4* src = dec_src(C, 2, tid); DEC_LOAD(v, src, w);
    }
    bf16x8 a[2][16];
#pragma unroll
    for (int dt = 0; dt < 2; ++dt)
#pragma unroll
        for (int s = 0; s < 16; ++s) a[dt][s] = *(const bf16x8*)(WUKT + (size_t)(256 * (h >> 2) + 128 * dt + 32 * (h & 3) + l31) * 256 + 16 * s + 8 * hh);
    f32x16 acc = zero16(); float lrow = 0.f;
    __builtin_amdgcn_s_waitcnt(0x0F70);
    DC_BAR();
    const int trq = (8 * hh + ((lane & 15) >> 2)) * DC_CP + (32 * w + 16 * ((lane >> 4) & 1) + 4 * (lane & 3)) * 2;
    static_assert(4 * DC_CP == 2112 && 16 * DC_CP == 8448 && 20 * DC_CP == 10560, "tr-read offsets");
#define DEC_PV(T_IMG, T_P) do { \
        const LAS unsigned char* pprev_ = C.lds + DC_PIMG + (T_P) * DC_PIMG_BYTES; \
        const unsigned taddr_ = (unsigned)(unsigned long)(C.lds + DC_CIMG + (T_IMG) * DC_IMG + trq); \
        v4i16_t b00, b01, b10, b11; \
        asm volatile("ds_read_b64_tr_b16 %0, %4\n\tds_read_b64_tr_b16 %1, %4 offset:2112\n\tds_read_b64_tr_b16 %2, %4 offset:8448\n\tds_read_b64_tr_b16 %3, %4 offset:10560" \
                     : "=&v"(b00), "=&v"(b01), "=&v"(b10), "=&v"(b11) : "v"(taddr_) : "memory"); \
        const unsigned x0_ = *(const LAS unsigned*)(pprev_ + (4 * w + (lane >> 4)) * DC_PP + (lane & 15) * 4); \
        const bf16x8 pa0_ = *(const LAS bf16x8*)(pprev_ + l31 * DC_PP + hh * 16), pa1_ = *(const LAS bf16x8*)(pprev_ + l31 * DC_PP + hh * 16 + 32); \
        DEC_PV_EXTRA \
        lrow += bflo(x0_) + bfhi(x0_); \
        { const bf16x8 bb = {b00[0], b00[1], b00[2], b00[3], b01[0], b01[1], b01[2], b01[3]}; acc = MFMA32(pa0_, bb, acc); } \
        { const bf16x8 bb = {b10[0], b10[1], b10[2], b10[3], b11[0], b11[1], b11[2], b11[3]}; acc = MFMA32(pa1_, bb, acc); } } while (0)
    int p3 = 0;
#pragma unroll 1
    for (int s = 0; s < DC_NSTEP; ++s) {
        const LAS unsigned char* cimg = C.lds + DC_CIMG + (s & 3) * DC_IMG; const LAS unsigned char* kpe = cimg + DC_CIMG_BYTES;
        const int pm2 = p3 == 2 ? 0 : p3 + 1;
        bf16x8 bq[4]; f32x16 k0, k1;
        const int xn = s + 2 + (grpB ? 1 : 0);
        const int pgn = *(const LAS int*)(C.lds + DC_PTAB + ((xn >> 2) & 31) * 4);
#define DEC_PV_EXTRA { const LAS unsigned char* cb_ = cimg + l31 * DC_CP + hh * 16; bq[0] = *(const LAS bf16x8*)cb_; bq[1] = *(const LAS bf16x8*)(cb_ + 32); bq[2] = *(const LAS bf16x8*)(cb_ + 64); bq[3] = *(const LAS bf16x8*)(cb_ + 96); }
        DEC_PV((s + 2) & 3, pm2);
#undef DEC_PV_EXTRA
        dec_A(a, bq, cimg, lane, k0, k1);
        if (grpB) DC_BAR();
        __builtin_amdgcn_s_setprio(3);
        dec_H2(C, k0, k1, kpe, C.lds + DC_PIMG + p3 * DC_PIMG_BYTES, w, lane, bnd);
        { const int x = s + 1 + (grpB ? 1 : 0);
          if (x < DC_NSTEP) {
            dec_put(v, C.lds + DC_CIMG + (x & 3) * DC_IMG, w, po);
            asm volatile("" ::: "memory");
            if (x + 1 < DC_NSTEP) { const f32x4* src = dec_src_pg(C, pgn, x + 1, tid); DEC_LOAD(v, src, w); }
          } }
        __builtin_amdgcn_s_setprio(0);
        if (!grpB) DC_BAR();
        p3 = pm2;
    }
    DC_BAR();
#define DEC_PV_EXTRA
    DEC_PV((DC_NSTEP - 2) & 3, (DC_NSTEP - 2) % 3);
    DEC_PV((DC_NSTEP - 1) & 3, (DC_NSTEP - 1) % 3);
#undef DEC_PV_EXTRA
#undef DEC_PV
    float* PART = C.p<float>(WS_PART) + (size_t)cu * 32 * 256; float* PARTL = C.p<float>(WS_PARTL) + cu * 32;
    { int l2 = lane; asm volatile("" : "+v"(l2)); const int e31 = l2 & 31, eh = l2 >> 5;
#pragma unroll
    for (int r = 0; r < 16; ++r) PART[((r & 3) + 8 * (r >> 2) + 4 * eh) * 256 + 32 * w + e31] = acc[r]; }
    lrow += __shfl_xor(lrow, 1); lrow += __shfl_xor(lrow, 2); lrow += __shfl_xor(lrow, 4); lrow += __shfl_xor(lrow, 8);
    if ((lane & 15) == 0) PARTL[4 * w + (lane >> 4)] = lrow;
    __syncthreads();
}
__device__ __forceinline__ void p_mla_decode_fin(const Ctx& C) {
    const float bnd = C.p<float>(WS_BND)[0]; const int lane = C.lane, w = C.wave, qd = w & 3;
    const bf16_t* QF = C.p<bf16_t>(WS_QF); const bf16_t* KN = C.p<bf16_t>(WS_KN); const bf16_t* KPE = C.p<bf16_t>(WS_KPE); bf16_t* O = C.p<bf16_t>(WS_O);
    const float* PART = C.p<float>(WS_PART); const float* PARTL = C.p<float>(WS_PARTL); const float* ROWS = C.out + (size_t)T * DM;
    LAS float* red = (LAS float*)C.lds;
    for (int task0 = 2 * blockIdx.x; task0 < DB * HA; task0 += 2 * gridDim.x) {
        const int task = task0 + (w >> 2), h = task & 15, b = task >> 4, c = 64 * qd + lane;
        float latv[4];
#pragma unroll
        for (int t = 0; t < 4; ++t) {
            const int rho = 4 * (h & 7) + t, tok = TP + b * DS + t;
            float acc = 0.f, l = 0.f;
#pragma unroll
            for (int k = 0; k < 4; ++k) { const int cu = dec_cu_of(4 * b + k, h >> 3); acc += PART[((size_t)cu * 32 + rho) * 256 + c]; l += PARTL[cu * 32 + rho]; }
            const bf16_t* q = QF + ((size_t)tok * 16 + h) * 96;
            const float q0 = bf2f(q[lane]), q1 = lane < 32 ? bf2f(q[64 + lane]) : 0.f;
            for (int j = 0; j <= t; ++j) { const int tk = TP + b * DS + j;
                float dd = q0 * bf2f(KN[(size_t)tk * 1024 + h * 64 + lane]) + (lane < 32 ? q1 * bf2f(KPE[(size_t)tk * 32 + lane]) : 0.f);
                dd = wave_sum(dd); const float p = __builtin_amdgcn_exp2f(dd - bnd); l += p;
                acc += p * ROWS[(size_t)tk * DCKV + c]; }
            latv[t] = acc / l;
        }
        float o0 = 0.f, o1 = 0.f, o2 = 0.f, o3 = 0.f;
        const float* wp = C.w_uv() + (size_t)(64 * qd) * 1024 + h * 64 + lane;
#pragma unroll
        for (int cc = 0; cc < 64; ++cc) { const float wv = wp[(size_t)cc * 1024];
            o0 += __builtin_bit_cast(float, __builtin_amdgcn_readlane(__builtin_bit_cast(int, latv[0]), cc)) * wv; o1 += __builtin_bit_cast(float, __builtin_amdgcn_readlane(__builtin_bit_cast(int, latv[1]), cc)) * wv;
            o2 += __builtin_bit_cast(float, __builtin_amdgcn_readlane(__builtin_bit_cast(int, latv[2]), cc)) * wv; o3 += __builtin_bit_cast(float, __builtin_amdgcn_readlane(__builtin_bit_cast(int, latv[3]), cc)) * wv; }
        red[(w * 4 + 0) * 64 + lane] = o0; red[(w * 4 + 1) * 64 + lane] = o1; red[(w * 4 + 2) * 64 + lane] = o2; red[(w * 4 + 3) * 64 + lane] = o3;
        __syncthreads();
        { const int wb = w & 4; float s = 0.f;
#pragma unroll
          for (int k = 0; k < 4; ++k) s += red[((wb + k) * 4 + qd) * 64 + lane];
          O[(size_t)(TP + b * DS + qd) * 1024 + h * 64 + lane] = (bf16_t)f2bf(s); }
        __syncthreads();
    }
}
}
namespace mk {
constexpr int NPHASE = 19;
__global__ void __launch_bounds__(NTHR, 2) mk_fwd(Args a) {
    extern __shared__ __attribute__((aligned(16))) unsigned char lds_raw[];
    Ctx C{(LAS unsigned char*)lds_raw, (int)threadIdx.x, (int)(threadIdx.x & 63), __builtin_amdgcn_readfirstlane((int)(threadIdx.x >> 6)), 0, 0, a.ws, a.out, a};
    C.gw = blockIdx.x * NWAVES + C.wave; C.ngw = gridDim.x * NWAVES;
    volatile LAS unsigned* misc = (volatile LAS unsigned*)(C.lds + MISC_OFF);
    if (C.tid < 32) misc[C.tid] = 0u;
    __syncthreads();
    XcdBarrier bar = xcd_barrier_post((unsigned*)(a.ws + WS_CTL) + CW_BAR + a.li * XCD_BAR_WORDS, misc + 8);
    if (a.never) cg::this_grid().sync();
    const int lo = a.ph_lo, hi = a.ph_hi;
#ifndef PH_MASK
#define PH_MASK 0xFFFFFFu
#endif
#define IN(k) ((((PH_MASK) >> (k)) & 1u) && lo <= (k) && (k) < hi)
#ifndef REP_MASK
#define REP_MASK 0u
#endif
#define REFRESH() do { C.lane = lane_id_fresh(); C.tid = C.wave * 64 + C.lane; } while (0)
#define PH(k, ...) if (IN(k)) { REFRESH(); __VA_ARGS__ } if (IN(k) && ((((REP_MASK) >> (k)) & 1u) != 0u)) { REFRESH(); __VA_ARGS__ }
#define SEAM(k) do { if (IN(k) && (k) + 1 < hi) xcd_barrier(bar); } while (0)
#define HB C.p<bf16_t>(WS_HB)
#define ACT C.p<bf16_t>(WS_ACT)
#define O C.p<bf16_t>(WS_O)

#define XS (C.x_sample() - (size_t)TP * DM)
#ifndef REP_ATTN
#define REP_ATTN 1
#endif
#define SS1 C.p<float>(WS_SS)
#define SS2 (C.p<float>(WS_SS) + T)
#define SS3 (C.p<float>(WS_SS) + 2 * T)
    PH(0,  p0_prologue(C); p_norm_x(C); ) SEAM(0);
    PH(1,  const float* cosA = C.p<float>(WS_ROPE); FPostA f{C.p<bf16_t>(WS_CQ), C.p<bf16_t>(WS_CKV), C.p<bf16_t>(WS_KPE), C.p<float>(WS_SS) + 3 * T, C.p<float>(WS_SS) + 4 * T, C.out + (size_t)T * DM, C.g_qc(), C.g_ckv(), C.g_kr(), cosA, cosA + NPOS * 16};
        big_gemm(C.lds, HB, C.p<bf16_t>(WS_WAIN), TP, 768, 1024, f, C.wave); skinny_gemm(C.lds, HB, C.p<bf16_t>(WS_WAIN), 768, 1024, f, C.wave, C.lane, 192); ) SEAM(1);
    PH(3,
        if (!(a.flags & 16384)) { FMlaQN f{C.p<bf16_t>(WS_QF), C.g_qn(), C.p<float>(WS_SS) + 3 * T};
          big_gemm(C.lds, C.p<bf16_t>(WS_CQ), C.p<bf16_t>(WS_WUQ), TP, 1024, 384, f, C.wave); skinny_gemm(C.lds, C.p<bf16_t>(WS_CQ), C.p<bf16_t>(WS_WUQ), 1024, 384, f, C.wave, C.lane); }
        if (!(a.flags & 32768)) { const float* cosA = C.p<float>(WS_ROPE); FMlaQR f{C.p<bf16_t>(WS_QF), C.g_qr(), cosA, cosA + NPOS * 16, C.p<float>(WS_SS) + 3 * T};
          big_gemm(C.lds, C.p<bf16_t>(WS_CQ), C.p<bf16_t>(WS_WUQ) + (size_t)1024 * 384, TP, 512, 384, f, C.wave);
          skinny_gemm(C.lds, C.p<bf16_t>(WS_CQ), C.p<bf16_t>(WS_WUQ) + (size_t)1024 * 384, 512, 384, f, C.wave, C.lane, 128); }
        if (!(a.flags & 65536)) { FKnV f{C.p<bf16_t>(WS_KN), C.p<bf16_t>(WS_KNRAW), C.g_kn(), C.p<float>(WS_SS) + 4 * T}; big_gemm(C.lds, C.p<bf16_t>(WS_CKV), C.p<bf16_t>(WS_WUK), TP, 2048, 256, f, C.wave); skinny_gemm(C.lds, C.p<bf16_t>(WS_CKV), C.p<bf16_t>(WS_WUK), 1024, 256, f, C.wave, C.lane); }
        if (!(a.flags & 131072)) p_rows_out(C);
    ) SEAM(3);
    PH(5,  if (!(a.flags & 256)) { p_mla_attn_prompt(C); if (REP_ATTN > 1) p_mla_attn_prompt(C); }
           if (!(a.flags & 512)) p_mla_decode(C); ) SEAM(5);
    PH(6,  p_mla_decode_fin(C); ) SEAM(6);
    PH(7,  { FResid<0, false> f{nullptr, C.x_prompt(), HB, SS1}; big_gemm(C.lds, O, C.p<bf16_t>(WS_WAOUT), TP, 1024, 1024, f, C.wave); }
           { FResid<0, false> f{nullptr, XS, HB, SS1}; skinny_gemm(C.lds, O, C.p<bf16_t>(WS_WAOUT), 1024, 1024, f, C.wave, C.lane); } ) SEAM(7);
    PH(9,  FSwiglu f{ACT, SS1}; big_gemm(C.lds, HB, C.p<bf16_t>(WS_WFIN0), TP, 5632, 1024, f, C.wave); skinny_gemm(C.lds, HB, C.p<bf16_t>(WS_WFIN0), 5632, 1024, f, C.wave, C.lane, 128); ) SEAM(9);
    PH(10, FResid<1, false> f{nullptr, nullptr, HB, SS2}; big_gemm(C.lds, ACT, C.p<bf16_t>(WS_WFOUT0), TP, 1024, 2816, f, C.wave); skinny_gemm(C.lds, ACT, C.p<bf16_t>(WS_WFOUT0), 1024, 2816, f, C.wave, C.lane); ) SEAM(10);
    PH(12, { const float* cosB = C.p<float>(WS_ROPE) + NPOS * 32; FKvq f{C.p<bf16_t>(WS_KS), C.p<bf16_t>(WS_VS), C.p<bf16_t>(WS_QBF), SS2, C.g_k_b(), C.g_q_b(), cosB, cosB + NPOS * 8, C.out}; big_gemm(C.lds, HB, C.p<bf16_t>(WS_WKVQ), TP, 1536, 1024, f, C.wave); skinny_gemm(C.lds, HB, C.p<bf16_t>(WS_WKVQ), 1536, 1024, f, C.wave, C.lane, 128); }
 ) SEAM(12);
    PH(14, p_swa_attn(C); ) SEAM(14);
    PH(15, FResid<1, false> f{nullptr, nullptr, HB, SS3}; big_gemm(C.lds, O, C.p<bf16_t>(WS_WBOUT), TP, 1024, 1024, f, C.wave); skinny_gemm(C.lds, O, C.p<bf16_t>(WS_WBOUT), 1024, 1024, f, C.wave, C.lane); ) SEAM(15);
    PH(17, FSwiglu f{ACT, SS3}; big_gemm(C.lds, HB, C.p<bf16_t>(WS_WFIN1), TP, 5632, 1024, f, C.wave); skinny_gemm(C.lds, HB, C.p<bf16_t>(WS_WFIN1), 5632, 1024, f, C.wave, C.lane, 128); ) SEAM(17);
    PH(18, FResid<1, true> f{C.out, nullptr, HB, nullptr}; big_gemm(C.lds, ACT, C.p<bf16_t>(WS_WFOUT1), TP, 1024, 2816, f, C.wave); skinny_gemm(C.lds, ACT, C.p<bf16_t>(WS_WFOUT1), 1024, 2816, f, C.wave, C.lane); )
#undef IN
#undef HB
#undef ACT
#undef O
#undef SS1
#undef SS2
#undef SS3
#undef XS
#undef SEAM
}
static int g_grid = 0;
static void launch_phases(void* const* d_in, void* d_out, void* d_ws, hipStream_t stream, int lo, int hi, int li, int flags = 0) {
    if (g_grid == 0) {
        int dev = 0, cus = 0, per_cu = 0;
        (void)hipGetDevice(&dev); (void)hipDeviceGetAttribute(&cus, hipDeviceAttributeMultiprocessorCount, dev);
        (void)hipFuncSetAttribute((const void*)mk_fwd, hipFuncAttributeMaxDynamicSharedMemorySize, LDS_BYTES);
        (void)hipOccupancyMaxActiveBlocksPerMultiprocessor(&per_cu, (const void*)mk_fwd, NTHR, LDS_BYTES);
        (void)hipGetLastError();
        g_grid = cus * (per_cu >= 1 ? 1 : 0); if (g_grid > 256) g_grid = 256;
        if (g_grid != 256) fprintf(stderr, "kernel_launch: grid %d (cus %d per_cu %d): this kernel is written for 256 CUs\n", g_grid, cus, per_cu);
    }
    Args a{};
    for (int i = 0; i < 28; ++i) a.in[i] = d_in[i];
    a.out = (float*)d_out; a.ws = (unsigned char*)d_ws; a.ph_lo = lo; a.ph_hi = hi; a.li = li; a.never = 0; a.flags = flags;
    void* args[] = {&a};
    hipError_t e = hipLaunchCooperativeKernel((const void*)mk_fwd, dim3(g_grid), dim3(NTHR), args, LDS_BYTES, stream);
    if (e != hipSuccess) fprintf(stderr, "kernel_launch: cooperative launch failed: %s (grid %d)\n", hipGetErrorString(e), g_grid);
}
}
#ifndef MK_DEBUG
#define MK_DEBUG 0
#endif
#if MK_DEBUG
__global__ void k_bf16_to_f32(const bf16_t* in, float* out, size_t n, float scale) {
    size_t i = (size_t)blockIdx.x * blockDim.x + threadIdx.x; if (i < n) out[i] = __builtin_bit_cast(float, (unsigned)in[i] << 16) * scale; }
__global__ void k_copy_f32(const float* in, float* out, size_t n) { size_t i = (size_t)blockIdx.x * blockDim.x + threadIdx.x; if (i < n) out[i] = in[i]; }
__global__ void k_vt_to_v(const bf16_t* vt, float* V) { size_t i = (size_t)blockIdx.x * blockDim.x + threadIdx.x; if (i >= (size_t)mk::TP * 1024) return;
    size_t t = i / 1024, c = i % 1024; V[i] = __builtin_bit_cast(float, (unsigned)vt[c * mk::TP + t] << 16); }
static void cvt(hipStream_t st, const bf16_t* in, float* out, size_t n, float scale = 1.f) { hipLaunchKernelGGL(k_bf16_to_f32, dim3((unsigned)((n + 255) / 256)), dim3(256), 0, st, in, out, n, scale); }
#endif
extern "C" void kernel_launch(void* const* d_in, const int* in_sizes, int n_in, void* d_out, int out_size, void* d_ws, size_t ws_size, hipStream_t stream) {
    (void)in_sizes; (void)n_in; (void)out_size; (void)ws_size;
    (void)hipMemsetAsync((char*)d_ws + mk::WS_CTL, 0, mk::CTL_ZERO_BYTES, stream);
#if MK_DEBUG == 0
    mk::launch_phases(d_in, d_out, d_ws, stream, 0, mk::NPHASE, 0);
#else
    unsigned char* ws = (unsigned char*)d_ws; void* nvws = ws + ((size_t)1536 << 20);
    using namespace mk;
#if MK_DEBUG == 1
    nv::nv_run(d_in, d_out, nvws, stream, 2);
    launch_phases(d_in, d_out, d_ws, stream, 0, 3, 0);
#elif MK_DEBUG == 2
    nv::nv_run(d_in, d_out, nvws, stream, 0);
    launch_phases(d_in, d_out, d_ws, stream, 0, 5, 0);
    cvt(stream, (const bf16_t*)(ws + WS_QF), nv::g_nv.Q, (size_t)T * 1536, 1.f / (SCALE_A * LOG2E));
    cvt(stream, (const bf16_t*)(ws + WS_KN), nv::g_nv.KN, (size_t)T * 1024);
    hipLaunchKernelGGL(k_vt_to_v, dim3(TP * 1024 / 256), dim3(256), 0, stream, (const bf16_t*)(ws + WS_VT), nv::g_nv.V);
    nv::nv_attn_only(d_in, nvws, stream);
    nv::nv_run(d_in, d_out, nvws, stream, 1);
#elif MK_DEBUG == 3
    nv::nv_run(d_in, d_out, nvws, stream, 0);
    launch_phases(d_in, d_out, d_ws, stream, 0, 7, 0);
    cvt(stream, (const bf16_t*)(ws + WS_O), nv::g_nv.O, (size_t)T * 1024);
    nv::nv_run(d_in, d_out, nvws, stream, 1);
#elif MK_DEBUG == 4
    nv::nv_run(d_in, d_out, nvws, stream, 2);
    launch_phases(d_in, d_out, d_ws, stream, 0, 14, 0);
#elif MK_DEBUG == 6
    nv::nv_run(d_in, d_out, nvws, stream, 2);
#ifndef EXP_PHASE
#define EXP_PHASE 5
#endif
    launch_phases(d_in, d_out, d_ws, stream, 0, EXP_PHASE, 0);
#ifndef EXP_REPS
#define EXP_REPS 10
#endif
#ifndef EXP_FLAGS
#define EXP_FLAGS 0
#endif
    for (int r = 0; r < EXP_REPS; ++r) launch_phases(d_in, d_out, d_ws, stream, EXP_PHASE, EXP_PHASE + 1, 1 + r, EXP_FLAGS);
#elif MK_DEBUG == 5
    nv::nv_run(d_in, d_out, nvws, stream, 2);
    launch_phases(d_in, d_out, d_ws, stream, 0, NPHASE, 0);
#endif
#endif
}
```

```cpp
#include <hip/hip_runtime.h>
#include <hip/hip_cooperative_groups.h>
#include <cstdio>
#include <cstdint>
#include <cmath>
namespace cg = cooperative_groups;
#define LAS __attribute__((address_space(3)))
typedef unsigned short bf16_t;
typedef short bf16x8 __attribute__((ext_vector_type(8)));
typedef float f32x4 __attribute__((ext_vector_type(4)));
typedef float f32x16 __attribute__((ext_vector_type(16)));
typedef unsigned u32x2 __attribute__((ext_vector_type(2)));
typedef unsigned u32x4 __attribute__((ext_vector_type(4)));

namespace mk {
constexpr int DM = 1024, NB = 8, SEQ = 2048, DB = 32, DS = 4, PAST = 16384, PAGE = 128, NPAGES = 128;
constexpr int TP = NB * SEQ, TS = DB * DS, T = TP + TS;
constexpr int HA = 16, DQC = 384, DC = 256, DCKV = 288, DQH = 96;
constexpr int HB = 16, NKV = 4, WIN = 128, DFF = 2816;
constexpr float EPS = 1e-6f;
constexpr int NPOS = SEQ + DS;
constexpr float LOG2E = 1.4426950408889634f;
constexpr float SCALE_A = 0.10206207261596575f, SCALE_B = 0.125f;
constexpr int NWAVES = 8, NTHR = 512;

__device__ __forceinline__ unsigned f2bf(float f) { unsigned u = __builtin_bit_cast(unsigned, f); return (u + 0x7fffu + ((u >> 16) & 1u)) >> 16; }
typedef float f32x2_t __attribute__((ext_vector_type(2))); typedef __bf16 bf16x2_t __attribute__((ext_vector_type(2)));
__device__ __forceinline__ unsigned pk2(float lo, float hi) { const f32x2_t v = {lo, hi}; const bf16x2_t b = __builtin_convertvector(v, bf16x2_t); return __builtin_bit_cast(unsigned, b); }
__device__ __forceinline__ float bf2f(unsigned b) { return __builtin_bit_cast(float, b << 16); }
__device__ __forceinline__ float bflo(unsigned w) { return __builtin_bit_cast(float, w << 16); }
__device__ __forceinline__ float bfhi(unsigned w) { return __builtin_bit_cast(float, w & 0xffff0000u); }
__device__ __forceinline__ float wave_sum(float v) {
#pragma unroll
    for (int o = 1; o < 64; o <<= 1) v += __shfl_xor(v, o);
    return v;
}
__device__ __forceinline__ int lane_id_fresh() { int l; asm volatile("v_mbcnt_lo_u32_b32 %0, -1, 0\n\tv_mbcnt_hi_u32_b32 %0, -1, %0" : "=v"(l)); return l; }
__device__ __forceinline__ int tok_pidx(int t) { return t < TP ? (t % SEQ) : (SEQ + (t - TP) % DS); }

#define XB_TMO      128
#define XB_XCNT(j)  (256  + 64 * (j))
#define XB_XSUB(j)  (1280 + 64 * (j))
#define XB_XGEN(j)  (2304 + 64 * (j))
#define XB_TOP      3328
#define XB_TOPGEN   3392
#define XCD_BAR_WORDS 3456
#define XB_SPIN_CAP (1u << 18)
__device__ __forceinline__ unsigned xb_ld(unsigned* p)              { return __hip_atomic_load(p, __ATOMIC_RELAXED, __HIP_MEMORY_SCOPE_AGENT); }
__device__ __forceinline__ unsigned xb_add(unsigned* p, unsigned v) { return __hip_atomic_fetch_add(p, v, __ATOMIC_RELAXED, __HIP_MEMORY_SCOPE_AGENT); }
__device__ __forceinline__ unsigned xb_xcc_id() { return (unsigned)__builtin_amdgcn_s_getreg((3 << 11) | 20) & 0xFu; }
#define XB_SPIN(cond, bar) do { unsigned _sp = 0; while (cond) { __builtin_amdgcn_s_sleep(1); \
    if ((++_sp & 255u) == 0u) { if (xb_ld(&(bar)[XB_TMO])) break; if (_sp > XB_SPIN_CAP) { atomicAdd(&(bar)[XB_TMO], 1u); break; } } } } while (0)
struct XcdBarrier { unsigned* bar; unsigned x; volatile LAS unsigned* st; };
__device__ __forceinline__ XcdBarrier xcd_barrier_post(unsigned* bar, volatile LAS unsigned* st) {
    XcdBarrier b; b.bar = bar; b.x = xb_xcc_id(); b.st = st;
    if (threadIdx.x == 0) (void)xb_add(&bar[XB_XCNT(b.x)], 1u);
    return b;
}
__device__ __forceinline__ void xcd_barrier_complete(unsigned* bar, unsigned x, unsigned& nloc, unsigned& nx) {
    const unsigned G = gridDim.x * gridDim.y * gridDim.z;
    unsigned sum, cnt, mine, sp = 0u;
    for (;;) {
        sum = 0u; cnt = 0u; mine = 0u;
#pragma unroll
        for (unsigned j = 0; j < 16; ++j) { const unsigned c = xb_ld(&bar[XB_XCNT(j)]); sum += c; cnt += (c > 0u) ? 1u : 0u; mine = (j == x) ? c : mine; }
        if (sum == G) break;
        __builtin_amdgcn_s_sleep(1);
        if ((++sp & 255u) == 0u) { if (xb_ld(&bar[XB_TMO])) break; if (sp > XB_SPIN_CAP) { atomicAdd(&bar[XB_TMO], 1u); break; } }
    }
    nloc = mine > 0u ? mine : 1u; nx = cnt > 0u ? cnt : 1u;
}
__device__ __forceinline__ void xcd_barrier(const XcdBarrier& b) {
    asm volatile("s_waitcnt vmcnt(0)" ::: "memory");
    __syncthreads();
    if (threadIdx.x == 0) {
        unsigned* bar = b.bar;
        __builtin_amdgcn_s_waitcnt(0);
        unsigned nloc = b.st[0], nx = b.st[1];
        if (nloc == 0u) { xcd_barrier_complete(bar, b.x, nloc, nx); b.st[0] = nloc; b.st[1] = nx; }
        const unsigned old = xb_add(&bar[XB_XSUB(b.x)], 1u);
        const unsigned gen = old / nloc;
        if (old + 1u == (gen + 1u) * nloc) {
            __builtin_amdgcn_fence(__ATOMIC_RELEASE, "agent");
            asm volatile("s_waitcnt vmcnt(0)" ::: "memory");
            const unsigned og = xb_add(&bar[XB_TOP], 1u);
            const unsigned tg = og / nx;
            if (og + 1u == (tg + 1u) * nx) xb_add(&bar[XB_TOPGEN], 1u);
            else XB_SPIN(xb_ld(&bar[XB_TOPGEN]) == tg, bar);
            __builtin_amdgcn_fence(__ATOMIC_ACQUIRE, "agent");
            xb_add(&bar[XB_XGEN(b.x)], 1u);
            asm volatile("s_waitcnt vmcnt(0)" ::: "memory");
        } else {
            XB_SPIN(xb_ld(&bar[XB_XGEN(b.x)]) == gen, bar);
            __builtin_amdgcn_fence(__ATOMIC_ACQUIRE, "agent");
            asm volatile("s_waitcnt vmcnt(0)" ::: "memory");
        }
    }
    __syncthreads();
}
}
namespace pg8 {
#define PG8_LAS __attribute__((address_space(3)))
constexpr int BM = 256, BK = 64, HALF = 128, HTB = HALF * BK * 2, STAGE_BYTES = 8 * HTB, NXCD = 8, WGM = 8;
__host__ __device__ __forceinline__ int lds_byte(int r, int c) { const int st = (r >> 4) * 2 + (c >> 5), rr = r & 15, cc = c & 31, ob = rr * 64 + cc * 2; return st * 1024 + (ob ^ (((ob >> 9) & 1) << 5)); }
__host__ __device__ __forceinline__ void stage_rc(int b, int& R, int& C) { const int st = b / 1024, sb = b % 1024, swz = sb ^ (((sb >> 9) & 1) << 5); R = (st >> 1) * 16 + swz / 64; C = (st & 1) * 32 + (swz % 64) / 2; }
__host__ __device__ __forceinline__ int perm32(int rho) { const int n = rho >> 4, i = rho & 15; return 8 * (i >> 2) + 4 * n + (i & 3); }

struct Unit { int pm, pn; };
struct Gemm { const bf16_t* A; const bf16_t* Bt; int M, N, K; };

struct StaticOrder {
    int nM, nN, nwg, G, c;
    __host__ __device__ void init(int M, int N, int G_, int c_) { nM = M / BM; nN = N / BM; nwg = nM * nN; G = G_; c = c_; }
    __host__ __device__ bool next(int i, Unit& u) const {
        const long L = (long)i * G + c; if (L >= nwg) return false;
        int wgid = (int)L; { const int q = nwg / NXCD, r = nwg % NXCD, xcd = wgid % NXCD, off = wgid / NXCD; wgid = (xcd < r ? xcd * (q + 1) : r * (q + 1) + (xcd - r) * q) + off; }
        const int nig = WGM * nN, gid = wgid / nig, fm = gid * WGM, gsz = (nM - fm) < WGM ? (nM - fm) : WGM;
        u.pm = fm + ((wgid % nig) % gsz); u.pn = (wgid % nig) / gsz; return true;
    }
    __device__ __forceinline__ void a_ready(const Unit&) const {}
    __device__ __forceinline__ void done(const Unit&) const {}
};
template <class Epi, class Sched, bool ALIGN_EPI = false, bool SP2 = false>
__device__ __forceinline__ void gemm_phase(PG8_LAS unsigned char* lds, const Gemm g, const Sched& S, const Epi& E, const int wave_id) {
    const int lane = mk::lane_id_fresh(), wid = wave_id, tid = wid * 64 + lane,     wr = wid >> 2, wc = wid & 3, fr = lane & 15, fq = lane >> 4;
    const int K = g.K, nt = K / BK;
    unsigned voffA[2], voffB[2];
#pragma unroll
    for (int i = 0; i < 2; ++i) { int R, C; stage_rc(tid * 16 + i * 8192, R, C); const int Rb = Epi::PERM ? ((R & ~31) + perm32(R & 31)) : R;
        voffA[i] = (unsigned)(R * K + C) * 2u; voffB[i] = (unsigned)(Rb * K + C) * 2u; }
    const size_t kstep = (size_t)(BK * 2);
    const size_t hstep = (size_t)HALF * K * 2;
    const size_t tstep = 2 * hstep;
    const unsigned ldsw = (unsigned)wid * 1024u;
    const int aoff = lds_byte(wr * 64 + fr, fq * 8), boff = lds_byte(wc * 32 + fr, fq * 8);
#define PG8_SA(b, h) (((b) * 2 + (h)) * HTB)
#define PG8_SB(b, h) ((4 + (b) * 2 + (h)) * HTB)
#define PG8_STAGE(bufoff, gbase, voff) do { _Pragma("unroll") for (int _i = 0; _i < 2; ++_i) \
        __builtin_amdgcn_global_load_lds((const unsigned*)((const char*)(gbase) + (voff)[_i]), (PG8_LAS unsigned*)(lds + (bufoff) + ldsw + _i * 8192), 16, 0, 0); } while (0)
#define PG8_LDA(dst, b, h) do { _Pragma("unroll") for (int m = 0; m < 4; ++m) _Pragma("unroll") for (int k = 0; k < 2; ++k) dst[m][k] = *(const PG8_LAS bf16x8*)(lds + PG8_SA(b, h) + aoff + m * 2048 + k * 1024); } while (0)
#define PG8_LDB(dst, b, h) do { _Pragma("unroll") for (int n = 0; n < 2; ++n) _Pragma("unroll") for (int k = 0; k < 2; ++k) dst[n][k] = *(const PG8_LAS bf16x8*)(lds + PG8_SB(b, h) + boff + n * 2048 + k * 1024); } while (0)
#define PG8_MMA(ai, bj, At, Bt) do { __builtin_amdgcn_s_setprio(1); _Pragma("unroll") for (int m = 0; m < 4; ++m) _Pragma("unroll") for (int n = 0; n < 2; ++n) _Pragma("unroll") for (int k = 0; k < 2; ++k) \
        acc[ai][bj][m][n] = __builtin_amdgcn_mfma_f32_16x16x32_bf16(Bt[n][k], At[m][k], acc[ai][bj][m][n], 0, 0, 0); __builtin_amdgcn_s_setprio(0); } while (0)
#define PG8_WAIT_V(n) asm volatile("s_waitcnt vmcnt(" #n ")" ::: "memory")
#define PG8_WAIT_L(n) asm volatile("s_waitcnt lgkmcnt(" #n ")" ::: "memory")
#define PG8_BAR __builtin_amdgcn_s_barrier()
#define PG8_SCHED __builtin_amdgcn_sched_barrier(0)
    Unit cur, nxt; int ui = 0;
    if (!S.next(0, cur)) return;
    f32x4 acc[2][2][4][2];
#pragma unroll
    for (int a = 0; a < 2; ++a)
#pragma unroll
        for (int b = 0; b < 2; ++b)
#pragma unroll
            for (int m = 0; m < 4; ++m)
#pragma unroll
                for (int n = 0; n < 2; ++n) acc[a][b][m][n] = (f32x4){0.f, 0.f, 0.f, 0.f};
    bf16x8 At[4][2], B0[2][2], B1[2][2];
    const char* cA = (const char*)g.A + (size_t)cur.pm * tstep; const char* cB = (const char*)g.Bt + (size_t)cur.pn * tstep;
    S.a_ready(cur);
    if constexpr (SP2) {
        PG8_STAGE(PG8_SB(0, 0), cB, voffB); PG8_STAGE(PG8_SB(0, 1), cB + hstep, voffB); PG8_STAGE(PG8_SA(0, 0), cA, voffA); PG8_STAGE(PG8_SA(0, 1), cA + hstep, voffA);
        if (wr == 1) PG8_BAR;
        PG8_WAIT_V(2); PG8_BAR;
        PG8_STAGE(PG8_SB(1, 0), cB + kstep, voffB); PG8_STAGE(PG8_SA(1, 0), cA + kstep, voffA); PG8_STAGE(PG8_SB(1, 1), cB + hstep + kstep, voffB);
        PG8_WAIT_V(6); PG8_BAR;
    } else {
        PG8_STAGE(PG8_SB(0, 0), cB, voffB); PG8_STAGE(PG8_SA(0, 0), cA, voffA); PG8_STAGE(PG8_SB(0, 1), cB + hstep, voffB); PG8_STAGE(PG8_SA(0, 1), cA + hstep, voffA);
        if (wr == 1) PG8_BAR;
        PG8_WAIT_V(4); PG8_BAR;
        PG8_STAGE(PG8_SB(1, 0), cB + kstep, voffB); PG8_STAGE(PG8_SA(1, 0), cA + kstep, voffA); PG8_STAGE(PG8_SB(1, 1), cB + hstep + kstep, voffB);
        PG8_WAIT_V(6); PG8_BAR;
    }
    for (;;) {
        const bool has_next = S.next(ui + 1, nxt);
        const char* nA = has_next ? (const char*)g.A + (size_t)nxt.pm * tstep : cA; const char* nB = has_next ? (const char*)g.Bt + (size_t)nxt.pn * tstep : cB;
        for (int t = 0; t < nt; t += 2) {
            const bool last = (t == nt - 2);
            const char* a1 = cA + (size_t)(t + 1) * kstep;
            const char* a2 = last ? nA : cA + (size_t)(t + 2) * kstep; const char* b2 = last ? nB : cB + (size_t)(t + 2) * kstep;
            const char* a3 = a2 + kstep; const char* b3 = b2 + kstep;
            if (last && has_next) S.a_ready(nxt);
            if constexpr (SP2) {
            PG8_LDB(B0, 0, 0); PG8_LDB(B1, 0, 1); PG8_SCHED; PG8_LDA(At, 0, 0); PG8_STAGE(PG8_SA(1, 1), a1 + hstep, voffA);
            PG8_WAIT_V(8); PG8_WAIT_L(0); PG8_BAR; PG8_MMA(0, 0, At, B0); PG8_MMA(0, 1, At, B1); PG8_BAR; PG8_SCHED;
            PG8_LDA(At, 0, 1); PG8_STAGE(PG8_SB(0, 0), b2, voffB); PG8_STAGE(PG8_SB(0, 1), b2 + hstep, voffB); PG8_STAGE(PG8_SA(0, 0), a2, voffA);
            PG8_WAIT_V(8); PG8_WAIT_L(0); PG8_BAR; PG8_MMA(1, 0, At, B0); PG8_MMA(1, 1, At, B1); PG8_BAR; PG8_SCHED;
            PG8_LDB(B0, 1, 0); PG8_LDB(B1, 1, 1); PG8_SCHED; PG8_LDA(At, 1, 0); PG8_STAGE(PG8_SA(0, 1), a2 + hstep, voffA);
            PG8_WAIT_V(8); PG8_WAIT_L(0); PG8_BAR; PG8_MMA(0, 0, At, B0); PG8_MMA(0, 1, At, B1); PG8_BAR; PG8_SCHED;
            PG8_LDA(At, 1, 1); PG8_STAGE(PG8_SB(1, 0), b3, voffB); PG8_STAGE(PG8_SB(1, 1), b3 + hstep, voffB); PG8_STAGE(PG8_SA(1, 0), a3, voffA);
            PG8_WAIT_V(8); PG8_WAIT_L(0); PG8_BAR; PG8_MMA(1, 0, At, B0); PG8_MMA(1, 1, At, B1); PG8_BAR; PG8_SCHED;
            } else {
            PG8_LDB(B0, 0, 0); PG8_SCHED; PG8_LDA(At, 0, 0); PG8_STAGE(PG8_SA(1, 1), a1 + hstep, voffA);
            PG8_WAIT_L(8); PG8_BAR; PG8_WAIT_L(0); PG8_MMA(0, 0, At, B0); PG8_BAR; PG8_SCHED;
            PG8_LDB(B1, 0, 1); PG8_STAGE(PG8_SB(0, 0), b2, voffB);
            PG8_BAR; PG8_WAIT_L(0); PG8_MMA(0, 1, At, B1); PG8_BAR;
            PG8_LDA(At, 0, 1); PG8_STAGE(PG8_SA(0, 0), a2, voffA);
            PG8_BAR; PG8_WAIT_L(0); PG8_MMA(1, 0, At, B0); PG8_BAR; PG8_SCHED;
            PG8_STAGE(PG8_SB(0, 1), b2 + hstep, voffB);
            PG8_WAIT_V(6); PG8_BAR; PG8_MMA(1, 1, At, B1); PG8_BAR;
            PG8_LDB(B0, 1, 0); PG8_SCHED; PG8_LDA(At, 1, 0); PG8_STAGE(PG8_SA(0, 1), a2 + hstep, voffA);
            PG8_WAIT_L(8); PG8_BAR; PG8_WAIT_L(0); PG8_MMA(0, 0, At, B0); PG8_BAR; PG8_SCHED;
            PG8_LDB(B1, 1, 1); PG8_STAGE(PG8_SB(1, 0), b3, voffB);
            PG8_BAR; PG8_WAIT_L(0); PG8_MMA(0, 1, At, B1); PG8_BAR;
            PG8_LDA(At, 1, 1); PG8_STAGE(PG8_SA(1, 0), a3, voffA);
            PG8_BAR; PG8_WAIT_L(0); PG8_MMA(1, 0, At, B0); PG8_BAR; PG8_SCHED;
            PG8_STAGE(PG8_SB(1, 1), b3 + hstep, voffB);
            PG8_WAIT_V(6); PG8_BAR; PG8_MMA(1, 1, At, B1); PG8_BAR;
            }
        }
        if constexpr (ALIGN_EPI) { if (wr == 0) PG8_BAR; }
        if constexpr (!Epi::AFTER_DRAIN) { E(acc, cur, wr, wc, fr, fq); S.done(cur); }
        if (!has_next) break;
#pragma unroll
        for (int a = 0; a < 2; ++a)
#pragma unroll
            for (int b = 0; b < 2; ++b)
#pragma unroll
                for (int m = 0; m < 4; ++m)
#pragma unroll
                    for (int n = 0; n < 2; ++n) acc[a][b][m][n] = (f32x4){0.f, 0.f, 0.f, 0.f};
        cur = nxt; cA = nA; cB = nB; ++ui;
        if constexpr (ALIGN_EPI) { if (wr == 1) PG8_BAR; }
    }
    PG8_WAIT_V(0);
    if constexpr (!ALIGN_EPI) { if (wr == 0) PG8_BAR; }
    PG8_BAR;
    if constexpr (Epi::AFTER_DRAIN) { E.fused(acc, cur, wr, wc, fr, fq, lds, wid, lane); S.done(cur); }
#undef PG8_SA
#undef PG8_SB
#undef PG8_STAGE
#undef PG8_LDA
#undef PG8_LDB
#undef PG8_MMA
#undef PG8_WAIT_V
#undef PG8_WAIT_L
#undef PG8_BAR
#undef PG8_SCHED
}
}
namespace mk {
using pg8::Unit;
__device__ __forceinline__ float ss_to_r(float ss) { return rsqrtf(ss * (1.f / DM) + EPS); }
__device__ __forceinline__ u32x2 pk4(f32x4 v) { return (u32x2){pk2(v[0], v[1]), pk2(v[2], v[3])}; }
__device__ __forceinline__ float sq4(f32x4 v) { return (v[0] * v[0] + v[1] * v[1]) + (v[2] * v[2] + v[3] * v[3]); }
__device__ __forceinline__ float quad_sum(float s) { s += __shfl_xor(s, 16); s += __shfl_xor(s, 32); return s; }
struct FStoreF32 { float* out; int ldc;
    __device__ __forceinline__ void rowquad(int row, int ct, int wc, int fq, f32x4 a00, f32x4 a01, f32x4 a10, f32x4 a11) const {
        float* p = out + (size_t)row * ldc + ct + 32 * wc + 4 * fq; *(f32x4*)p = a00; *(f32x4*)(p + 16) = a01; *(f32x4*)(p + 128) = a10; *(f32x4*)(p + 144) = a11; } };
template <int RES, bool OUTF> struct FResid { float* out; const float* resf; bf16_t* hb; float* ss;
    __device__ __forceinline__ f32x4 ld(size_t o) const { if (RES == 0) return *(const f32x4*)(resf + o); const u32x2 r = *(const u32x2*)(hb + o); return (f32x4){bflo(r.x), bfhi(r.x), bflo(r.y), bfhi(r.y)}; }
    __device__ __forceinline__ void rowquad(int row, int ct, int wc, int fq, f32x4 a00, f32x4 a01, f32x4 a10, f32x4 a11) const {
        const size_t o = (size_t)row * DM + ct + 32 * wc + 4 * fq;
        a00 += ld(o); a01 += ld(o + 16); a10 += ld(o + 128); a11 += ld(o + 144);
        if (OUTF) { *(f32x4*)(out + o) = a00; *(f32x4*)(out + o + 16) = a01; *(f32x4*)(out + o + 128) = a10; *(f32x4*)(out + o + 144) = a11; }
        else { *(u32x2*)(hb + o) = pk4(a00); *(u32x2*)(hb + o + 16) = pk4(a01); *(u32x2*)(hb + o + 128) = pk4(a10); *(u32x2*)(hb + o + 144) = pk4(a11);
            const float st = quad_sum((sq4(a00) + sq4(a01)) + (sq4(a10) + sq4(a11))); if (fq == 0) atomicAdd(ss + row, st); } } };
__device__ __forceinline__ float silu_f(float g) { return g * __builtin_amdgcn_rcpf(1.0f + __expf(-g)); }
struct FSwiglu { bf16_t* out; const float* ss;
    __device__ __forceinline__ void rowquad(int row, int ct, int wc, int fq, f32x4 a00, f32x4 a01, f32x4 a10, f32x4 a11) const {
#ifdef EXP_NOEPI
        { const f32x4 sm = (a00 + a01) + (a10 + a11); if (sm[0] + sm[1] + sm[2] + sm[3] == 12345.678f) out[row] = 1; return; }
#endif
#ifdef EXP_NOSS
        const float rs = 1.f;
#else
        const float rs = ss_to_r(ss[row]);
#endif
        a00 *= rs; a01 *= rs; a10 *= rs; a11 *= rs;
        bf16_t* p = out + (size_t)row * DFF + (ct >> 1) + 32 * wc + 4 * fq;
        *(u32x2*)p = (u32x2){pk2(silu_f(a00[0]) * a10[0], silu_f(a00[1]) * a10[1]), pk2(silu_f(a00[2]) * a10[2], silu_f(a00[3]) * a10[3])};
        *(u32x2*)(p + 16) = (u32x2){pk2(silu_f(a01[0]) * a11[0], silu_f(a01[1]) * a11[1]), pk2(silu_f(a01[2]) * a11[2], silu_f(a01[3]) * a11[3])}; } };
__device__ __forceinline__ void head_store4(bf16_t* p, const float* g, float rn, f32x4 a00, f32x4 a01, f32x4 a10, f32x4 a11) {
    *(u32x2*)p = pk4(a00 * rn * *(const f32x4*)g); asm volatile("" ::: "memory");
    *(u32x2*)(p + 16) = pk4(a01 * rn * *(const f32x4*)(g + 16)); asm volatile("" ::: "memory");
    *(u32x2*)(p + 32) = pk4(a10 * rn * *(const f32x4*)(g + 32)); asm volatile("" ::: "memory");
    *(u32x2*)(p + 48) = pk4(a11 * rn * *(const f32x4*)(g + 48)); }
struct FPostA { bf16_t* cq; bf16_t* ckv; bf16_t* kpe; float* ssq; float* sskv; float* rows; const float* g_qc; const float* g_ckv; const float* g_kr; const float* cosA; const float* sinA;
    __device__ __forceinline__ void rowquad(int row, int ct, int wc, int fq, f32x4 a00, f32x4 a01, f32x4 a10, f32x4 a11) const {
        const int pn = ct >> 8, cb = 32 * wc + 4 * fq;
        if (pn == 0) { const float st = quad_sum((sq4(a00) + sq4(a01)) + (sq4(a10) + sq4(a11))); if (fq == 0) atomicAdd(ssq + row, st);
            bf16_t* p = cq + (size_t)row * DQC + cb; const float* g = g_qc + cb;
            *(u32x2*)p = pk4(a00 * *(const f32x4*)g); *(u32x2*)(p + 16) = pk4(a01 * *(const f32x4*)(g + 16)); *(u32x2*)(p + 128) = pk4(a10 * *(const f32x4*)(g + 128)); *(u32x2*)(p + 144) = pk4(a11 * *(const f32x4*)(g + 144)); }
        else if (pn == 2) { const float st = quad_sum((sq4(a00) + sq4(a01)) + (sq4(a10) + sq4(a11))); if (fq == 0) atomicAdd(sskv + row, st);
            bf16_t* p = ckv + (size_t)row * DC + cb; const float* g = g_ckv + cb;
            *(u32x2*)p = pk4(a00 * *(const f32x4*)g); *(u32x2*)(p + 16) = pk4(a01 * *(const f32x4*)(g + 16)); *(u32x2*)(p + 128) = pk4(a10 * *(const f32x4*)(g + 128)); *(u32x2*)(p + 144) = pk4(a11 * *(const f32x4*)(g + 144)); }
        else { const float st = quad_sum(sq4(a00) + sq4(a01)); if (fq == 0) atomicAdd(ssq + row, st);
            bf16_t* p = cq + (size_t)row * DQC + 256 + cb; const float* g = g_qc + 256 + cb;
            *(u32x2*)p = pk4(a00 * *(const f32x4*)g); *(u32x2*)(p + 16) = pk4(a01 * *(const f32x4*)(g + 16));
            if (wc == 0) { const float r = rsqrtf(quad_sum(sq4(a10) + sq4(a11)) * (1.f / 32) + EPS); const int pi = tok_pidx(row);
                const f32x4 v1 = a10 * r * *(const f32x4*)(g_kr + 4 * fq), v2 = a11 * r * *(const f32x4*)(g_kr + 16 + 4 * fq);
                const f32x4 c = *(const f32x4*)(cosA + pi * 16 + 4 * fq), s = *(const f32x4*)(sinA + pi * 16 + 4 * fq);
                const f32x4 o1 = v1 * c - v2 * s, o2 = v2 * c + v1 * s;
                *(u32x2*)(kpe + (size_t)row * 32 + 4 * fq) = pk4(o1); *(u32x2*)(kpe + (size_t)row * 32 + 16 + 4 * fq) = pk4(o2);
                *(f32x4*)(rows + (size_t)row * DCKV + DC + 4 * fq) = o1; *(f32x4*)(rows + (size_t)row * DCKV + DC + 16 + 4 * fq) = o2; } } } };
struct FMlaQN { bf16_t* qf; const float* g_qn; const float* ssq;
    __device__ __forceinline__ void rowquad(int row, int ct, int wc, int fq, f32x4 a00, f32x4 a01, f32x4 a10, f32x4 a11) const {
        { const float rq = rsqrtf(ssq[row] * (1.f / DQC) + EPS); a00 *= rq; a01 *= rq; a10 *= rq; a11 *= rq; }
        const int head = (ct >> 6) + wc; const float rn = rsqrtf(quad_sum((sq4(a00) + sq4(a01)) + (sq4(a10) + sq4(a11))) * (1.f / 64) + EPS) * (SCALE_A * LOG2E);
        head_store4(qf + ((size_t)row * 16 + head) * 96 + 4 * fq, g_qn + 4 * fq, rn, a00, a01, a10, a11); } };
struct FMlaQR { bf16_t* qf; const float* g_qr; const float* cosA; const float* sinA; const float* ssq;
    __device__ __forceinline__ void half(int row, int head, int fq, f32x4 x1, f32x4 x2) const {
        { const float rq = rsqrtf(ssq[row] * (1.f / DQC) + EPS); x1 *= rq; x2 *= rq; }
        const float r = rsqrtf(quad_sum(sq4(x1) + sq4(x2)) * (1.f / 32) + EPS) * (SCALE_A * LOG2E);
        const int pi = tok_pidx(row);
        x1 = x1 * r * *(const f32x4*)(g_qr + 4 * fq); x2 = x2 * r * *(const f32x4*)(g_qr + 16 + 4 * fq);
        const f32x4 c = *(const f32x4*)(cosA + pi * 16 + 4 * fq), s = *(const f32x4*)(sinA + pi * 16 + 4 * fq);
        bf16_t* p = qf + ((size_t)row * 16 + head) * 96 + 64 + 4 * fq; *(u32x2*)p = pk4(x1 * c - x2 * s); *(u32x2*)(p + 16) = pk4(x2 * c + x1 * s);
        asm volatile("" ::: "memory"); }
    __device__ __forceinline__ void rowquad(int row, int ct, int wc, int fq, f32x4 a00, f32x4 a01, f32x4 a10, f32x4 a11) const {
        const int h0 = 8 * (ct >> 8) + wc; half(row, h0, fq, a00, a01); half(row, h0 + 4, fq, a10, a11); } };
struct FKnV { bf16_t* kn; bf16_t* knv; const float* g_kn; const float* sskv;
    __device__ __forceinline__ void rowquad(int row, int ct, int wc, int fq, f32x4 a00, f32x4 a01, f32x4 a10, f32x4 a11) const {
        { const float rk = rsqrtf(sskv[row] * (1.f / DC) + EPS); a00 *= rk; a01 *= rk; a10 *= rk; a11 *= rk; }
        if (ct < 1024) { const int head = (ct >> 6) + wc; const float rn = rsqrtf(quad_sum((sq4(a00) + sq4(a01)) + (sq4(a10) + sq4(a11))) * (1.f / 64) + EPS);
            head_store4(kn + (size_t)row * 1024 + head * 64 + 4 * fq, g_kn + 4 * fq, rn, a00, a01, a10, a11); }
        else { bf16_t* p = knv + (size_t)row * 2048 + ct + 32 * wc + 4 * fq; *(u32x2*)p = pk4(a00); *(u32x2*)(p + 16) = pk4(a01); *(u32x2*)(p + 128) = pk4(a10); *(u32x2*)(p + 144) = pk4(a11); } } };
struct FKvq { bf16_t* ks; bf16_t* vs; bf16_t* qbf; const float* ss; const float* g_k; const float* g_q; const float* cosB; const float* sinB; float* out;
    __device__ __forceinline__ void winptr(int row, float*& wk, float*& wv) const {
        float* out_wkp = out + (size_t)T * DM + (size_t)T * DCKV; float* out_wvp = out_wkp + (size_t)NB * WIN * 256; float* out_wks = out_wvp + (size_t)NB * WIN * 256; float* out_wvs = out_wks + (size_t)DB * WIN * 256;
        wk = nullptr; wv = nullptr;
        if (row < TP) { const int b = row / SEQ, s = row % SEQ; if (s >= SEQ - WIN) { wk = out_wkp + ((size_t)b * WIN + (s - (SEQ - WIN))) * 256; wv = out_wvp + ((size_t)b * WIN + (s - (SEQ - WIN))) * 256; } }
        else { const int b = (row - TP) / DS, tt = (row - TP) % DS; wk = out_wks + ((size_t)b * WIN + (WIN - DS) + tt) * 256; wv = out_wvs + ((size_t)b * WIN + (WIN - DS) + tt) * 256; } }
    __device__ __forceinline__ void rowquad(int row, int ct, int wc, int fq, f32x4 a00, f32x4 a01, f32x4 a10, f32x4 a11) const {
        const float rs = ss_to_r(ss[row]); a00 *= rs; a01 *= rs; a10 *= rs; a11 *= rs;
        const int pn = ct >> 8;
        if (pn == 1) { float* wk; float* wv; winptr(row, wk, wv); const int cb = 32 * wc + 4 * fq;
            bf16_t* p = vs + (size_t)row * 256 + cb; *(u32x2*)p = pk4(a00); *(u32x2*)(p + 16) = pk4(a01); *(u32x2*)(p + 128) = pk4(a10); *(u32x2*)(p + 144) = pk4(a11);
            if (wv) { *(f32x4*)(wv + cb) = a00; *(f32x4*)(wv + cb + 16) = a01; *(f32x4*)(wv + cb + 128) = a10; *(f32x4*)(wv + cb + 144) = a11; }
            return; }
        const bool isk = pn == 0; const float* g = (isk ? g_k : g_q) + 4 * fq;
        const float rn = rsqrtf(quad_sum((sq4(a00) + sq4(a01)) + (sq4(a10) + sq4(a11))) * (1.f / 64) + EPS) * (isk ? 1.f : SCALE_B * LOG2E);
        a00 = a00 * rn * *(const f32x4*)g; a01 = a01 * rn * *(const f32x4*)(g + 16); a10 = a10 * rn * *(const f32x4*)(g + 32); a11 = a11 * rn * *(const f32x4*)(g + 48);
        { const int pi = tok_pidx(row); const f32x4 c = *(const f32x4*)(cosB + pi * 8 + 4 * (fq & 1)), s = *(const f32x4*)(sinB + pi * 8 + 4 * (fq & 1));
          f32x4 other; other[0] = __shfl_xor(a00[0], 32); other[1] = __shfl_xor(a00[1], 32); other[2] = __shfl_xor(a00[2], 32); other[3] = __shfl_xor(a00[3], 32);
          a00 = (fq < 2) ? (a00 * c - other * s) : (a00 * c + other * s); }
        if (isk) { float* wk; float* wv; winptr(row, wk, wv); const int cb = 64 * wc + 4 * fq;
            bf16_t* p = ks + (size_t)row * 256 + cb; *(u32x2*)p = pk4(a00); *(u32x2*)(p + 16) = pk4(a01); *(u32x2*)(p + 32) = pk4(a10); *(u32x2*)(p + 48) = pk4(a11);
            if (wk) { *(f32x4*)(wk + cb) = a00; *(f32x4*)(wk + cb + 16) = a01; *(f32x4*)(wk + cb + 32) = a10; *(f32x4*)(wk + cb + 48) = a11; } }
        else { bf16_t* p = qbf + (size_t)row * 1024 + (4 * (pn - 2) + wc) * 64 + 4 * fq; *(u32x2*)p = pk4(a00); *(u32x2*)(p + 16) = pk4(a01); *(u32x2*)(p + 32) = pk4(a10); *(u32x2*)(p + 48) = pk4(a11); } } };

template <class F> struct EpiAdapt {
    static constexpr bool PERM = false, AFTER_DRAIN = false; F f;
    __device__ __forceinline__ void operator()(const f32x4 (&acc)[2][2][4][2], const Unit& u, int wr, int wc, int fr, int fq) const {
        asm volatile("" : "+v"(fr), "+v"(fq));
#pragma unroll
        for (int ai = 0; ai < 2; ++ai)
#pragma unroll
            for (int m = 0; m < 4; ++m) { f.rowquad(u.pm * 256 + ai * 128 + wr * 64 + m * 16 + fr, u.pn * 256, wc, fq, acc[ai][0][m][0], acc[ai][0][m][1], acc[ai][1][m][0], acc[ai][1][m][1]); asm volatile("" ::: "memory"); }
    }
    __device__ __forceinline__ void fused(f32x4 (&)[2][2][4][2], const Unit&, int, int, int, int, PG8_LAS unsigned char*, int, int) const {}
};

template <class F, bool AL = true, bool SP = true> __device__ __forceinline__ void big_gemm(LAS unsigned char* lds, const bf16_t* A, const bf16_t* Bt, int M, int N, int K, const F& f, int wave_id) {
    pg8::Gemm g{A, Bt, M, N, K}; pg8::StaticOrder S; S.init(M, N, (int)gridDim.x, (int)blockIdx.x);
    EpiAdapt<F> E{f};
    pg8::gemm_phase<EpiAdapt<F>, pg8::StaticOrder, AL, SP>(lds, g, S, E, wave_id);
}
template <class F> __device__ __forceinline__ void skinny_gemm(LAS unsigned char* lds, const bf16_t* A, const bf16_t* Bt, int N, int K, const F& f, int wave, int lane_unused, int blk0 = 0) {
    const int lane = lane_id_fresh(); (void)lane_unused;
    const int fr = lane & 15, fq = lane >> 4, ntask = N / 8, nks = K / 32;
    LAS f32x4* red = (LAS f32x4*)lds;
    if ((int)blockIdx.x < blk0) return;
    for (int task = blockIdx.x - blk0; task < ntask; task += gridDim.x - blk0) {
        const int rg = task & 7, wc = (task >> 3) & 3, pn = task >> 5;
        const bf16_t* ap = A + (size_t)(TP + 16 * rg + fr) * K + 8 * fq;
        const bf16_t* bp = Bt + (size_t)(256 * pn + 32 * wc + fr) * K + 8 * fq;
        f32x4 acc[2][2];
#pragma unroll
        for (int bj = 0; bj < 2; ++bj)
#pragma unroll
            for (int n = 0; n < 2; ++n) acc[bj][n] = (f32x4){0.f, 0.f, 0.f, 0.f};
#pragma unroll 2
        for (int ks = wave; ks < nks; ks += 8) {
            const bf16x8 a = *(const bf16x8*)(ap + 32 * ks);
#pragma unroll
            for (int bj = 0; bj < 2; ++bj)
#pragma unroll
                for (int n = 0; n < 2; ++n) { const bf16x8 b = *(const bf16x8*)(bp + (size_t)(128 * bj + 16 * n) * K + 32 * ks);
                    acc[bj][n] = __builtin_amdgcn_mfma_f32_16x16x32_bf16(b, a, acc[bj][n], 0, 0, 0); }
        }
#pragma unroll
        for (int bj = 0; bj < 2; ++bj)
#pragma unroll
            for (int n = 0; n < 2; ++n) red[(wave * 4 + bj * 2 + n) * 64 + lane] = acc[bj][n];
        __syncthreads();
        if (wave == 0) {
            f32x4 v[4];
#pragma unroll
            for (int q = 0; q < 4; ++q) { v[q] = (f32x4){0.f, 0.f, 0.f, 0.f};
#pragma unroll
                for (int ww = 0; ww < 8; ++ww) v[q] += red[(ww * 4 + q) * 64 + lane]; }
            f.rowquad(TP + 16 * rg + fr, 256 * pn, wc, fq, v[0], v[1], v[2], v[3]);
        }
        __syncthreads();
    }
}

template <class F> __device__ __forceinline__ void wave_gemm64(const bf16_t* A, int M, const bf16_t* Bt, int N, int K, const F& f, int gw, int ngw, int lane_unused) {
    const int lane = lane_id_fresh(); (void)lane_unused;
    const int fr = lane & 15, fq = lane >> 4, ncol = N / 64, ntask = (M / 64) * ncol;
    for (int task = gw; task < ntask; task += ngw) {
        const int cg = task % ncol, rg = task / ncol, pn = cg >> 2, wc = cg & 3;
        const bf16_t* ap = A + (size_t)(64 * rg + fr) * K + 8 * fq;
        const bf16_t* bp = Bt + (size_t)(256 * pn + 32 * wc + fr) * K + 8 * fq;
        f32x4 acc[4][2][2];
#pragma unroll
        for (int rs = 0; rs < 4; ++rs)
#pragma unroll
            for (int bj = 0; bj < 2; ++bj)
#pragma unroll
                for (int n = 0; n < 2; ++n) acc[rs][bj][n] = (f32x4){0.f, 0.f, 0.f, 0.f};
#pragma unroll 2
        for (int ks = 0; ks < K / 32; ++ks) {
            bf16x8 a[4], b[2][2];
#pragma unroll
            for (int rs = 0; rs < 4; ++rs) a[rs] = *(const bf16x8*)(ap + (size_t)(16 * rs) * K + 32 * ks);
#pragma unroll
            for (int bj = 0; bj < 2; ++bj)
#pragma unroll
                for (int n = 0; n < 2; ++n) b[bj][n] = *(const bf16x8*)(bp + (size_t)(128 * bj + 16 * n) * K + 32 * ks);
#pragma unroll
            for (int rs = 0; rs < 4; ++rs)
#pragma unroll
                for (int bj = 0; bj < 2; ++bj)
#pragma unroll
                    for (int n = 0; n < 2; ++n) acc[rs][bj][n] = __builtin_amdgcn_mfma_f32_16x16x32_bf16(b[bj][n], a[rs], acc[rs][bj][n], 0, 0, 0);
        }
#pragma unroll
        for (int rs = 0; rs < 4; ++rs) f.rowquad(64 * rg + 16 * rs + fr, 256 * pn, wc, fq, acc[rs][0][0], acc[rs][0][1], acc[rs][1][0], acc[rs][1][1]);
    }
}

constexpr size_t MiB = 1u << 20;
constexpr size_t WS_CTL = 0, CTL_ZERO_BYTES = 256 * 1024;
constexpr size_t WS_BND = 512 * 1024;
constexpr size_t WS_ROPE = 1 * MiB;
constexpr size_t WS_WAIN = 2 * MiB, WS_WUQ = 4 * MiB, WS_WUK = 6 * MiB, WS_WUV = 6 * MiB + 512 * 1024, WS_WAOUT = 8 * MiB;
constexpr size_t WS_WFIN0 = 10 * MiB, WS_WFIN1 = 21 * MiB, WS_WFOUT0 = 32 * MiB, WS_WFOUT1 = 38 * MiB, WS_WKVQ = 44 * MiB, WS_WBOUT = 47 * MiB;
constexpr size_t WS_HB = 50 * MiB;
constexpr size_t WS_AF = 84 * MiB;
constexpr size_t WS_CQ = 136 * MiB;
constexpr size_t WS_CKV = 150 * MiB;
constexpr size_t WS_KPE = 160 * MiB;
constexpr size_t WS_QRAW = 162 * MiB;
constexpr size_t WS_KNRAW = 214 * MiB;
constexpr size_t WS_VT = 248 * MiB;
constexpr size_t WS_QF = 282 * MiB;
constexpr size_t WS_KN = 334 * MiB;
constexpr size_t WS_O = 368 * MiB;
constexpr size_t WS_PART = 402 * MiB;
constexpr size_t WS_PARTL = 418 * MiB;
constexpr size_t WS_H1 = 420 * MiB;
constexpr size_t WS_H2 = 486 * MiB;
constexpr size_t WS_ACT = 552 * MiB;
constexpr size_t WS_KVF = 642 * MiB;
constexpr size_t WS_QBRAW = 676 * MiB;
constexpr size_t WS_VST = 710 * MiB;
constexpr size_t WS_KS = 720 * MiB;
constexpr size_t WS_VS = 730 * MiB;
constexpr size_t WS_QBF = 740 * MiB;
constexpr size_t WS_SS = 776 * MiB;
constexpr size_t WS_END = 778 * MiB;
constexpr int CW_BAR = 4096;

constexpr int RING_BYTES = 131072, MISC_OFF = 163584, LDS_BYTES = 163840;

struct Args { const void* in[28]; float* out; unsigned char* ws; int ph_lo, ph_hi, li, never, flags, pad; };

struct Ctx {
    LAS unsigned char* lds; int tid, lane, wave, gw, ngw; unsigned char* ws; float* out;
    const Args& a;
    __device__ __forceinline__ const float* x_prompt() const { return (const float*)a.in[0]; }
    __device__ __forceinline__ const float* x_sample() const { return (const float*)a.in[1]; }
    __device__ __forceinline__ const float* cache() const { return (const float*)a.in[2]; }
    __device__ __forceinline__ const float* swk() const { return (const float*)a.in[3]; }
    __device__ __forceinline__ const float* swv() const { return (const float*)a.in[4]; }
    __device__ __forceinline__ const int* page_table() const { return (const int*)a.in[5]; }
    __device__ __forceinline__ const float* norm_attn() const { return (const float*)a.in[6]; }
    __device__ __forceinline__ const float* norm_ffn() const { return (const float*)a.in[7]; }
    __device__ __forceinline__ const float* w_a_in() const { return (const float*)a.in[8]; }
    __device__ __forceinline__ const float* g_qc() const { return (const float*)a.in[9]; }
    __device__ __forceinline__ const float* w_uq() const { return (const float*)a.in[10]; }
    __device__ __forceinline__ const float* g_ckv() const { return (const float*)a.in[11]; }
    __device__ __forceinline__ const float* w_uk() const { return (const float*)a.in[12]; }
    __device__ __forceinline__ const float* w_uv() const { return (const float*)a.in[13]; }
    __device__ __forceinline__ const float* g_qn() const { return (const float*)a.in[14]; }
    __device__ __forceinline__ const float* g_qr() const { return (const float*)a.in[15]; }
    __device__ __forceinline__ const float* g_kn() const { return (const float*)a.in[16]; }
    __device__ __forceinline__ const float* g_kr() const { return (const float*)a.in[17]; }
    __device__ __forceinline__ const float* w_a_out() const { return (const float*)a.in[18]; }
    __device__ __forceinline__ const float* g_kv() const { return (const float*)a.in[19]; }
    __device__ __forceinline__ const float* w_kv() const { return (const float*)a.in[20]; }
    __device__ __forceinline__ const float* g_k_b() const { return (const float*)a.in[21]; }
    __device__ __forceinline__ const float* w_q_b() const { return (const float*)a.in[22]; }
    __device__ __forceinline__ const float* g_q_b() const { return (const float*)a.in[23]; }
    __device__ __forceinline__ const float* sinks() const { return (const float*)a.in[24]; }
    __device__ __forceinline__ const float* w_b_out() const { return (const float*)a.in[25]; }
    __device__ __forceinline__ const float* w_ffn_in() const { return (const float*)a.in[26]; }
    __device__ __forceinline__ const float* w_ffn_out() const { return (const float*)a.in[27]; }
    template <class Tp> __device__ __forceinline__ Tp* p(size_t off) const { return (Tp*)(ws + off); }
};

__device__ __forceinline__ void p0_item(const float* W, int ldw, int K, bf16_t* WT, int d0, int s0, const float* gain, int kb, LAS float* scr, int lane) {
    const int k0 = 64 * kb;
#pragma unroll
    for (int u = 0; u < 8; ++u) { const int idx = lane + 64 * u, kk = idx >> 3, n4 = (idx & 7) * 4;
        f32x4 v = {0.f, 0.f, 0.f, 0.f}; if (s0 >= 0) { v = *(const f32x4*)(W + (size_t)(k0 + kk) * ldw + s0 + n4); if (gain) v *= gain[k0 + kk]; }
        LAS float* d = scr + kk * 33 + n4; d[0] = v[0]; d[1] = v[1]; d[2] = v[2]; d[3] = v[3]; }
    asm volatile("s_waitcnt lgkmcnt(0)" ::: "memory");
    const int c = lane & 7;
#pragma unroll
    for (int j = 0; j < 4; ++j) { const int n = (lane >> 3) + 8 * j; const LAS float* s = scr + (8 * c) * 33 + n;
        u32x4 o; o.x = pk2(s[0 * 33], s[1 * 33]); o.y = pk2(s[2 * 33], s[3 * 33]); o.z = pk2(s[4 * 33], s[5 * 33]); o.w = pk2(s[6 * 33], s[7 * 33]);
        *(u32x4*)(WT + (size_t)(d0 + n) * K + k0 + 8 * c) = o; }
    asm volatile("s_waitcnt lgkmcnt(0)" ::: "memory");
}
__device__ __forceinline__ void p0_job(const Ctx& C, LAS float* scr, const float* W, int ldw, int K, int nd, bf16_t* WT, int drow0, const float* gain, int map, int nsrc, int& base) {
    const int nblk = nd / 32, nit = (K / 64) * nblk;
    int it0 = C.gw - (base % C.ngw); if (it0 < 0) it0 += C.ngw;
    for (int it = it0; it < nit; it += C.ngw) {
        const int kb = it / nblk, nb = it % nblk, d0 = 32 * nb;
        int s0 = d0;
        const int pn = d0 >> 8, c0 = d0 & 255, mbj = c0 >> 7, mwc = (c0 >> 5) & 3;
        if (map == 1) s0 = (c0 < 128) ? 128 * pn + c0 : 2816 + 128 * pn + (c0 - 128);
        else if (map == 2) s0 = (pn < 4) ? (4 * pn + mwc) * 96 + 32 * mbj : (8 * (pn - 4) + 4 * mbj + mwc) * 96 + 64;
        else if (map == 3) s0 = (4 * pn + mwc) * 64 + 32 * mbj;
        else if (map == 4) s0 = (pn == 0) ? mwc * 64 + 32 * mbj : d0;
        else if (map == 5) s0 = (d0 < 384) ? d0 : (d0 == 384 ? 640 : (d0 < 512 ? 1 << 20 : d0 - 128));
        if (s0 >= nsrc) s0 = -1;
        p0_item(W, ldw, K, WT, drow0 + d0, s0, gain, kb, scr, C.lane);
    }
    base += nit;
}
__device__ __forceinline__ void p0_prologue(const Ctx& C) {
    LAS float* scr = (LAS float*)(C.lds + C.wave * 16384);
    int base = 0;
    p0_job(C, scr, C.w_a_in(), 672, 1024, 768, C.p<bf16_t>(WS_WAIN), 0, C.norm_attn(), 5, 672, base);
    p0_job(C, scr, C.w_uq(), 1536, 384, 1536, C.p<bf16_t>(WS_WUQ), 0, nullptr, 2, 1536, base);
    p0_job(C, scr, C.w_uk(), 1024, 256, 1024, C.p<bf16_t>(WS_WUK), 0, nullptr, 3, 1024, base);
    p0_job(C, scr, C.w_uv(), 1024, 256, 1024, C.p<bf16_t>(WS_WUV), 0, nullptr, 0, 1024, base);
    p0_job(C, scr, C.w_a_out(), 1024, 1024, 1024, C.p<bf16_t>(WS_WAOUT), 0, nullptr, 0, 1024, base);
    p0_job(C, scr, C.w_ffn_in(), 5632, 1024, 5632, C.p<bf16_t>(WS_WFIN0), 0, C.norm_ffn(), 1, 5632, base);
    p0_job(C, scr, C.w_ffn_in() + (size_t)1024 * 5632, 5632, 1024, 5632, C.p<bf16_t>(WS_WFIN1), 0, C.norm_ffn() + 1024, 1, 5632, base);
    p0_job(C, scr, C.w_ffn_out(), 1024, 2816, 1024, C.p<bf16_t>(WS_WFOUT0), 0, nullptr, 0, 1024, base);
    p0_job(C, scr, C.w_ffn_out() + (size_t)2816 * 1024, 1024, 2816, 1024, C.p<bf16_t>(WS_WFOUT1), 0, nullptr, 0, 1024, base);
    p0_job(C, scr, C.w_kv(), 512, 1024, 512, C.p<bf16_t>(WS_WKVQ), 0, C.g_kv(), 4, 512, base);
    p0_job(C, scr, C.w_q_b(), 1024, 1024, 1024, C.p<bf16_t>(WS_WKVQ), 512, C.norm_attn() + 1024, 3, 1024, base);
    p0_job(C, scr, C.w_b_out(), 1024, 1024, 1024, C.p<bf16_t>(WS_WBOUT), 0, nullptr, 0, 1024, base);
    { float* cosA = C.p<float>(WS_ROPE); float* sinA = cosA + NPOS * 16; float* cosB = sinA + NPOS * 16; float* sinB = cosB + NPOS * 8;
      for (int i = C.gw * 64 + C.lane; i < NPOS * 16; i += C.ngw * 64) {
          const int p = i / 16, j = i % 16; const float pos = (float)(p < SEQ ? p : PAST + (p - SEQ));
          { const float inv = (float)pow(500000.0, -(double)(2 * j) / 32.0); const float ang = pos * inv; cosA[i] = (float)cos((double)ang); sinA[i] = (float)sin((double)ang); }
          if (j < 8) { const float inv = (float)pow(500000.0, -(double)(2 * j) / 16.0); const float ang = pos * inv; cosB[p * 8 + j] = (float)cos((double)ang); sinB[p * 8 + j] = (float)sin((double)ang); }
      } }
    { float* ssz = C.p<float>(WS_SS); for (int i = C.gw * 64 + C.lane; i < 5 * T; i += C.ngw * 64) ssz[i] = 0.f; }
    { float* out_wks = C.out + (size_t)T * DM + (size_t)T * DCKV + (size_t)2 * NB * WIN * 256; float* out_wvs = out_wks + (size_t)DB * WIN * 256;
      for (size_t i = (size_t)C.gw * 64 + C.lane; i < (size_t)DB * (WIN - DS) * 256; i += (size_t)C.ngw * 64) { const size_t b = i / ((WIN - DS) * 256), r = i % ((WIN - DS) * 256);
          out_wks[b * WIN * 256 + r] = C.swk()[b * WIN * 256 + DS * 256 + r]; out_wvs[b * WIN * 256 + r] = C.swv()[b * WIN * 256 + DS * 256 + r]; } }
    if (C.gw == 0) {
        float a = fabsf(C.g_qn()[C.lane]), b = fabsf(C.g_kn()[C.lane]), c = C.lane < 32 ? fabsf(C.g_qr()[C.lane]) : 0.f, d = C.lane < 32 ? fabsf(C.g_kr()[C.lane]) : 0.f;
        float e = fabsf(C.g_q_b()[C.lane]), f = fabsf(C.g_k_b()[C.lane]), s = C.lane < 16 ? C.sinks()[C.lane] : -1e30f;
#pragma unroll
        for (int o = 1; o < 64; o <<= 1) { a = fmaxf(a, __shfl_xor(a, o)); b = fmaxf(b, __shfl_xor(b, o)); c = fmaxf(c, __shfl_xor(c, o)); d = fmaxf(d, __shfl_xor(d, o));
            e = fmaxf(e, __shfl_xor(e, o)); f = fmaxf(f, __shfl_xor(f, o)); s = fmaxf(s, __shfl_xor(s, o)); }
        if (C.lane == 0) { float* bnd = C.p<float>(WS_BND); bnd[0] = SCALE_A * LOG2E * (64.f * a * b + 32.f * c * d) * 1.02f; bnd[1] = fmaxf(SCALE_B * LOG2E * 64.f * e * f * 1.02f, s * LOG2E); }
    }
}
__device__ __forceinline__ void norm_row_bf16(const float* xrow, bf16_t* orow, int lane) {
    const f32x4* xr = (const f32x4*)xrow + lane; f32x4 v[4]; float s = 0.f;
#pragma unroll
    for (int j = 0; j < 4; ++j) { v[j] = xr[64 * j]; s += (v[j].x * v[j].x + v[j].y * v[j].y) + (v[j].z * v[j].z + v[j].w * v[j].w); }
    const float r = rsqrtf(wave_sum(s) * (1.f / DM) + EPS);
    u32x2* o = (u32x2*)orow + lane;
#pragma unroll
    for (int j = 0; j < 4; ++j) o[64 * j] = (u32x2){pk2(v[j].x * r, v[j].y * r), pk2(v[j].z * r, v[j].w * r)};
}
__device__ __forceinline__ void p_norm_x(const Ctx& C) {
    bf16_t* hb = C.p<bf16_t>(WS_HB);
    for (int t = C.gw; t < T; t += C.ngw) norm_row_bf16(t < TP ? C.x_prompt() + (size_t)t * DM : C.x_sample() + (size_t)(t - TP) * DM, hb + (size_t)t * DM, C.lane);
}
__device__ __forceinline__ void p_norm_h(const Ctx& C, const float* H) {
    bf16_t* hb = C.p<bf16_t>(WS_HB);
    for (int t = C.gw; t < T; t += C.ngw) norm_row_bf16(H + (size_t)t * DM, hb + (size_t)t * DM, C.lane);
}
__device__ __forceinline__ void p_rows_out(const Ctx& C) {
    const bf16_t* CKV = C.p<bf16_t>(WS_CKV); const float* sskv = C.p<float>(WS_SS) + 4 * T; float* ROWS = C.out + (size_t)T * DM; const int lane = lane_id_fresh();
    for (int t0 = 4 * C.gw; t0 < T; t0 += 4 * C.ngw) {
        u32x2 w[4]; float r[4];
#pragma unroll
        for (int i = 0; i < 4; ++i) { w[i] = *(const u32x2*)(CKV + (size_t)(t0 + i) * DC + 4 * lane); r[i] = sskv[t0 + i]; }
#pragma unroll
        for (int i = 0; i < 4; ++i) { const float rr = rsqrtf(r[i] * (1.f / DC) + EPS);
            *(f32x4*)(ROWS + (size_t)(t0 + i) * DCKV + 4 * lane) = (f32x4){bflo(w[i].x), bfhi(w[i].x), bflo(w[i].y), bfhi(w[i].y)} * rr; }
    }
}
__device__ __forceinline__ void p_post_a(const Ctx& C) {
    const float* AF = C.p<float>(WS_AF); bf16_t* CQ = C.p<bf16_t>(WS_CQ); bf16_t* CKV = C.p<bf16_t>(WS_CKV); bf16_t* KPE = C.p<bf16_t>(WS_KPE);
    float* ROWS = C.out + (size_t)T * DM; const float* cosA = C.p<float>(WS_ROPE); const float* sinA = cosA + NPOS * 16; const int lane = C.lane;
    for (int t = C.gw; t < T; t += C.ngw) {
        const float* a = AF + (size_t)t * 768;
        float q[6]; float s = 0.f;
#pragma unroll
        for (int i = 0; i < 6; ++i) { q[i] = a[lane + 64 * i]; s += q[i] * q[i]; }
        float r = rsqrtf(wave_sum(s) * (1.f / DQC) + EPS);
#pragma unroll
        for (int i = 0; i < 6; ++i) CQ[(size_t)t * DQC + lane + 64 * i] = (bf16_t)f2bf(q[i] * r * C.g_qc()[lane + 64 * i]);
        float k[4]; s = 0.f;
#pragma unroll
        for (int i = 0; i < 4; ++i) { k[i] = a[DQC + lane + 64 * i]; s += k[i] * k[i]; }
        r = rsqrtf(wave_sum(s) * (1.f / DC) + EPS);
#pragma unroll
        for (int i = 0; i < 4; ++i) { const float v = k[i] * r * C.g_ckv()[lane + 64 * i]; ROWS[(size_t)t * DCKV + lane + 64 * i] = v; CKV[(size_t)t * DC + lane + 64 * i] = (bf16_t)f2bf(v); }
        const float v = lane < 32 ? a[DQC + DC + lane] : 0.f;
        r = rsqrtf(wave_sum(v * v) * (1.f / 32) + EPS);
        const float vn = lane < 32 ? v * r * C.g_kr()[lane] : 0.f, other = __shfl_xor(vn, 16);
        const int p = tok_pidx(t), j = lane & 15; const float c = cosA[p * 16 + j], sn = sinA[p * 16 + j];
        const float o = (lane < 16) ? (vn * c - other * sn) : (vn * c + other * sn);
        if (lane < 32) { ROWS[(size_t)t * DCKV + DC + lane] = o; KPE[(size_t)t * 32 + lane] = (bf16_t)f2bf(o); }
    }
}
}
namespace mk {
__device__ __forceinline__ bf16x8 pack8(float a0, float a1, float a2, float a3, float a4, float a5, float a6, float a7) {
    u32x4 w = {pk2(a0, a1), pk2(a2, a3), pk2(a4, a5), pk2(a6, a7)}; return __builtin_bit_cast(bf16x8, w); }
#define MFMA32(a, b, c) __builtin_amdgcn_mfma_f32_32x32x16_bf16((a), (b), (c), 0, 0, 0)
__device__ __forceinline__ f32x16 zero16() { f32x16 z;
#pragma unroll
    for (int i = 0; i < 16; ++i) z[i] = 0.f; return z; }

constexpr int AT_KP = 208, AT_VP = 192, AT_KBYTES = 64 * AT_KP, AT_VBYTES = 64 * AT_VP, AT_BUF = AT_KBYTES + AT_VBYTES;
typedef short v4i16_t __attribute__((ext_vector_type(4)));
__device__ __forceinline__ void mla_attn_unit(const Ctx& C, int b, int h, int qb, float bnd) {
    const int tid = C.tid, lane = C.lane, w = C.wave, l31 = lane & 31, hh = lane >> 5;
    const bf16_t* QF = C.p<bf16_t>(WS_QF); const bf16_t* KN = C.p<bf16_t>(WS_KN); const bf16_t* KPE = C.p<bf16_t>(WS_KPE); const bf16_t* KNV = C.p<bf16_t>(WS_KNRAW); bf16_t* O = C.p<bf16_t>(WS_O);
    const size_t tokq = (size_t)b * SEQ + qb * 256 + 32 * w + l31;
    bf16x8 qf[6];
    { const bf16_t* qp = QF + (tokq * 16 + h) * 96 + 8 * hh;
#pragma unroll
      for (int s = 0; s < 6; ++s) qf[s] = *(const bf16x8*)(qp + 16 * s); }
    f32x16 oT[2]; oT[0] = zero16(); oT[1] = zero16(); float lsum = 0.f;
    f32x16 negb;
#pragma unroll
    for (int i = 0; i < 16; ++i) negb[i] = -bnd;
    const int ntile = 4 * (qb + 1), mylast = 4 * qb + (w >> 1);
    const bf16_t* gK = KN + ((size_t)b * SEQ + (tid >> 3)) * 1024 + h * 64 + (tid & 7) * 8;
    const bf16_t* gR = KPE + ((size_t)b * SEQ + ((tid & 255) >> 2)) * 32 + (tid & 3) * 8;
    const bf16_t* gV = KNV + ((size_t)b * SEQ + (tid >> 3)) * 2048 + 1024 + h * 64 + (tid & 7) * 8;
    const unsigned sK = (tid >> 3) * AT_KP + (tid & 7) * 16, sR = ((tid & 255) >> 2) * AT_KP + 128 + (tid & 3) * 16, sV = AT_KBYTES + (tid >> 3) * AT_VP + (tid & 7) * 16;
    u32x4 rkA, rrA = {0u, 0u, 0u, 0u}, rvA, rkB, rrB = {0u, 0u, 0u, 0u}, rvB;
#define AT_LOAD(K_, R_, V_, t_) do { K_ = *(const u32x4*)(gK + (size_t)(t_) * 64 * 1024); if (tid < 256) R_ = *(const u32x4*)(gR + (size_t)(t_) * 64 * 32); V_ = *(const u32x4*)(gV + (size_t)(t_) * 64 * 2048); } while (0)
#define AT_STORE(K_, R_, V_, b_) do { LAS unsigned char* d_ = C.lds + (b_) * AT_BUF; *(LAS u32x4*)(d_ + sK) = K_; if (tid < 256) *(LAS u32x4*)(d_ + sR) = R_; *(LAS u32x4*)(d_ + sV) = V_; } while (0)
    AT_LOAD(rkA, rrA, rvA, 0);
    if (ntile > 1) AT_LOAD(rkB, rrB, rvB, 1);
    AT_STORE(rkA, rrA, rvA, 0);
    __syncthreads();
    const int tr_off = (4 * hh + ((lane & 15) >> 2)) * AT_VP + (16 * ((lane >> 4) & 1) + 4 * (lane & 3)) * 2;
    int cur = 0;
    const bool grpB = w >= 4;
#define AT_STEP(LK_, LR_, LV_, SK_, SR_, SV_) do { const int nb1 = cur == 2 ? 0 : cur + 1; \
        if (jt + 2 < ntile) AT_LOAD(LK_, LR_, LV_, jt + 2); \
        at_S(jt); \
        if (grpB) { if (jt + 1 < ntile) AT_STORE(SK_, SR_, SV_, nb1); __syncthreads(); } \
        __builtin_amdgcn_s_setprio(2); at_PV(jt); __builtin_amdgcn_s_setprio(0); \
        if (!grpB) { if (jt + 1 < ntile) AT_STORE(SK_, SR_, SV_, nb1); __syncthreads(); } \
        cur = nb1; ++jt; } while (0)
    f32x16 p0, p1;
    auto at_S = [&](int jt) __attribute__((always_inline)) {
        if (jt <= mylast) {
            const LAS unsigned char* kb = C.lds + cur * AT_BUF + l31 * AT_KP + hh * 16;
            p0 = negb; p1 = negb;
#pragma unroll
            for (int s = 0; s < 6; ++s) { const bf16x8 a0 = *(const LAS bf16x8*)(kb + s * 32), a1 = *(const LAS bf16x8*)(kb + 32 * AT_KP + s * 32);
                p0 = MFMA32(a0, qf[s], p0); p1 = MFMA32(a1, qf[s], p1); }
        }
    };
    auto at_PV = [&](int jt) __attribute__((always_inline)) {
        if (jt <= mylast) {
            const bool diag = (jt == mylast); const int qrel = 32 * (w & 1) + l31;
            float e0[16], e1[16];
#pragma unroll
            for (int r = 0; r < 16; ++r) { const int kk = (r & 3) + 8 * (r >> 2) + 4 * hh;
                e0[r] = __builtin_amdgcn_exp2f(p0[r]); e1[r] = __builtin_amdgcn_exp2f(p1[r]);
                if (diag) { if (kk > qrel) e0[r] = 0.f; if (kk + 32 > qrel) e1[r] = 0.f; }
                lsum += e0[r] + e1[r]; }
            bf16x8 pb[2][2];
            pb[0][0] = pack8(e0[0], e0[1], e0[2], e0[3], e0[4], e0[5], e0[6], e0[7]); pb[0][1] = pack8(e0[8], e0[9], e0[10], e0[11], e0[12], e0[13], e0[14], e0[15]);
            pb[1][0] = pack8(e1[0], e1[1], e1[2], e1[3], e1[4], e1[5], e1[6], e1[7]); pb[1][1] = pack8(e1[8], e1[9], e1[10], e1[11], e1[12], e1[13], e1[14], e1[15]);
            const LAS unsigned char* vb = C.lds + cur * AT_BUF + AT_KBYTES + tr_off;
#pragma unroll
            for (int dt = 0; dt < 2; ++dt)
#pragma unroll
                for (int kh = 0; kh < 2; ++kh)
#pragma unroll
                    for (int ks = 0; ks < 2; ++ks) { const LAS unsigned char* ad = vb + (32 * kh + 16 * ks) * AT_VP + dt * 64;
                        const v4i16_t lo = __builtin_amdgcn_ds_read_tr16_b64_v4i16((LAS v4i16_t*)ad), hi = __builtin_amdgcn_ds_read_tr16_b64_v4i16((LAS v4i16_t*)(ad + 8 * AT_VP));
                        const bf16x8 av = {lo[0], lo[1], lo[2], lo[3], hi[0], hi[1], hi[2], hi[3]};
                        oT[dt] = MFMA32(av, pb[kh][ks], oT[dt]); }
        }
    };
    for (int jt = 0; jt < ntile;) {
        AT_STEP(rkA, rrA, rvA, rkB, rrB, rvB);
        AT_STEP(rkB, rrB, rvB, rkA, rrA, rvA);
    }
#undef AT_STEP
#undef AT_LOAD
#undef AT_STORE
    __syncthreads();
    lsum += __shfl_xor(lsum, 32); const float inv = 1.f / lsum;
    bf16_t* op = O + tokq * 1024 + h * 64 + 4 * hh;
#pragma unroll
    for (int dt = 0; dt < 2; ++dt)
#pragma unroll
        for (int g = 0; g < 4; ++g) *(u32x2*)(op + 32 * dt + 8 * g) = (u32x2){pk2(oT[dt][4 * g] * inv, oT[dt][4 * g + 1] * inv), pk2(oT[dt][4 * g + 2] * inv, oT[dt][4 * g + 3] * inv)};
}
__device__ __forceinline__ void p_mla_attn_prompt(const Ctx& C) {
    const float bnd = C.p<float>(WS_BND)[0];
    for (int u = blockIdx.x; u < NB * HA * 4; u += gridDim.x) {
        const int j = u & 3, h = (u >> 2) & 15, b = u >> 6;
        mla_attn_unit(C, b, h, 7 - j, bnd);
        mla_attn_unit(C, b, h, j, bnd);
    }
}

constexpr int SW_KP = 144, SW_VP = 192, SW_KBYTES = 256 * SW_KP;
struct SwaRegs { u32x4 k[4], v[4]; };
__device__ __forceinline__ void swa_load(const Ctx& C, int u, SwaRegs& R) {
    const int blk = u & 15, kvh = (u >> 4) & 3, b = u >> 6, tid = C.tid, kpos0 = 128 * (blk - 1);
    const bf16_t* KS = C.p<bf16_t>(WS_KS); const bf16_t* VSB = C.p<bf16_t>(WS_VS);
#pragma unroll
    for (int q = 0; q < 4; ++q) { const int i = tid + 512 * q, key = i >> 3, c = i & 7; const u32x4 z = {0u, 0u, 0u, 0u}; R.k[q] = z; R.v[q] = z;
        if (kpos0 + key >= 0) { const size_t o = ((size_t)b * SEQ + kpos0 + key) * 256 + kvh * 64 + c * 8; R.k[q] = *(const u32x4*)(KS + o); R.v[q] = *(const u32x4*)(VSB + o); } }
}
__device__ __forceinline__ void swa_store(const Ctx& C, const SwaRegs& R) {
    const int tid = C.tid;
#pragma unroll
    for (int q = 0; q < 4; ++q) { const int i = tid + 512 * q, key = i >> 3, c = i & 7;
        *(LAS u32x4*)(C.lds + key * SW_KP + c * 16) = R.k[q]; *(LAS u32x4*)(C.lds + SW_KBYTES + key * SW_VP + c * 16) = R.v[q]; }
}
__device__ __forceinline__ void swa_compute(const Ctx& C, int u, float bnd) {
    const int blk = u & 15, kvh = (u >> 4) & 3, b = u >> 6;
    const int lane = C.lane, w = C.wave, l31 = lane & 31, hh = lane >> 5;
    const bf16_t* QF = C.p<bf16_t>(WS_QBF); bf16_t* O = C.p<bf16_t>(WS_O);
    const int g = w >> 1, qh = w & 1, head = 4 * kvh + g;
    const float sk = __builtin_amdgcn_exp2f(C.sinks()[head] * LOG2E - bnd);
    if (w >= 4) __builtin_amdgcn_s_sleep(10);
#pragma unroll 1
    for (int rg = 0; rg < 2; ++rg) {
        const int qr0 = 64 * qh + 32 * rg + l31; const size_t tok = (size_t)b * SEQ + 128 * blk + qr0;
        bf16x8 qf[4];
#pragma unroll
        for (int s = 0; s < 4; ++s) qf[s] = *(const bf16x8*)(QF + tok * 1024 + head * 64 + 16 * s + 8 * hh);
        f32x16 oT[2]; oT[0] = zero16(); oT[1] = zero16(); float lsum = 0.f;
        int kt0 = qh ? 1 : 0; const int kt1 = qh ? 3 : 2; if (blk == 0 && kt0 < 2) kt0 = 2;
#pragma unroll 1
        for (int kt = kt0; kt <= kt1; ++kt) {
            const LAS unsigned char* kb = C.lds + (64 * kt + l31) * SW_KP + hh * 16;
            f32x16 p0 = zero16(), p1 = zero16();
#pragma unroll
            for (int s = 0; s < 4; ++s) { const bf16x8 a0 = *(const LAS bf16x8*)(kb + s * 32), a1 = *(const LAS bf16x8*)(kb + 32 * SW_KP + s * 32);
                p0 = MFMA32(a0, qf[s], p0); p1 = MFMA32(a1, qf[s], p1); }
            float e0[16], e1[16];
#pragma unroll
            for (int r = 0; r < 16; ++r) { const int kk = 64 * kt + (r & 3) + 8 * (r >> 2) + 4 * hh;
                e0[r] = (kk > qr0 && kk <= qr0 + 128) ? __builtin_amdgcn_exp2f(p0[r] - bnd) : 0.f;
                e1[r] = (kk + 32 > qr0 && kk + 32 <= qr0 + 128) ? __builtin_amdgcn_exp2f(p1[r] - bnd) : 0.f;
                lsum += e0[r] + e1[r]; }
            bf16x8 pb[2][2];
            pb[0][0] = pack8(e0[0], e0[1], e0[2], e0[3], e0[4], e0[5], e0[6], e0[7]); pb[0][1] = pack8(e0[8], e0[9], e0[10], e0[11], e0[12], e0[13], e0[14], e0[15]);
            pb[1][0] = pack8(e1[0], e1[1], e1[2], e1[3], e1[4], e1[5], e1[6], e1[7]); pb[1][1] = pack8(e1[8], e1[9], e1[10], e1[11], e1[12], e1[13], e1[14], e1[15]);
            const LAS unsigned char* vb = C.lds + SW_KBYTES + (64 * kt + 4 * hh + ((lane & 15) >> 2)) * SW_VP + (16 * ((lane >> 4) & 1) + 4 * (lane & 3)) * 2;
#pragma unroll
            for (int dt = 0; dt < 2; ++dt)
#pragma unroll
                for (int kh = 0; kh < 2; ++kh)
#pragma unroll
                    for (int ks = 0; ks < 2; ++ks) { const LAS unsigned char* ad = vb + (32 * kh + 16 * ks) * SW_VP + dt * 64;
                        const v4i16_t lo = __builtin_amdgcn_ds_read_tr16_b64_v4i16((LAS v4i16_t*)ad), hi = __builtin_amdgcn_ds_read_tr16_b64_v4i16((LAS v4i16_t*)(ad + 8 * SW_VP));
                        const bf16x8 av = {lo[0], lo[1], lo[2], lo[3], hi[0], hi[1], hi[2], hi[3]};
                        oT[dt] = MFMA32(av, pb[kh][ks], oT[dt]); }
        }
        lsum += __shfl_xor(lsum, 32); const float inv = 1.f / (lsum + sk);
        bf16_t* op = O + tok * 1024 + head * 64 + 4 * hh;
#pragma unroll
        for (int dt = 0; dt < 2; ++dt)
#pragma unroll
            for (int gg = 0; gg < 4; ++gg) *(u32x2*)(op + 32 * dt + 8 * gg) = (u32x2){pk2(oT[dt][4 * gg] * inv, oT[dt][4 * gg + 1] * inv), pk2(oT[dt][4 * gg + 2] * inv, oT[dt][4 * gg + 3] * inv)};
    }
}
constexpr int SS_KP = 65, SS_K = 0, SS_V = 132 * SS_KP * 4, SS_Q = SS_V + 132 * 64 * 4, SS_P = SS_Q + 16 * 64 * 4;
__device__ __forceinline__ void swa_sample(const Ctx& C, float bnd) {
    const bf16_t* QF = C.p<bf16_t>(WS_QBF); const bf16_t* KS = C.p<bf16_t>(WS_KS); const bf16_t* VS = C.p<bf16_t>(WS_VS); bf16_t* O = C.p<bf16_t>(WS_O);
    const int lane = C.lane, tid = C.tid, w = C.wave;
    LAS float* Kl = (LAS float*)(C.lds + SS_K); LAS float* Vl = (LAS float*)(C.lds + SS_V); LAS float* Ql = (LAS float*)(C.lds + SS_Q); LAS float* Pl = (LAS float*)(C.lds + SS_P) + w * 192;
    for (int u = blockIdx.x; u < DB * NKV; u += gridDim.x) {
        const int b = u >> 2, kvh = u & 3;
#pragma unroll
        for (int k = 0; k < 4; ++k) { const int i = tid + 512 * k, row = i >> 4, c = (i & 15) * 4;
            const f32x4 kv = *(const f32x4*)(C.swk() + ((size_t)(b * WIN + row) * NKV + kvh) * 64 + c), vv = *(const f32x4*)(C.swv() + ((size_t)(b * WIN + row) * NKV + kvh) * 64 + c);
            Kl[row * SS_KP + c] = kv[0]; Kl[row * SS_KP + c + 1] = kv[1]; Kl[row * SS_KP + c + 2] = kv[2]; Kl[row * SS_KP + c + 3] = kv[3];
            *(LAS f32x4*)(Vl + row * 64 + c) = vv; }
        if (tid < 256) { const int j = tid >> 6, i = tid & 63; const size_t src = ((size_t)(TP + b * DS + j) * NKV + kvh) * 64 + i;
            Kl[(128 + j) * SS_KP + i] = bf2f(KS[src]); Vl[(128 + j) * 64 + i] = bf2f(VS[src]); }
#pragma unroll
        for (int k = 0; k < 2; ++k) { const int i = tid + 512 * k, r = i >> 6, dd = i & 63, g = r >> 2, tt = r & 3;
            Ql[i] = bf2f(QF[(size_t)(TP + b * DS + tt) * 1024 + (4 * kvh + g) * 64 + dd]); }
        __syncthreads();
#pragma unroll 1
        for (int rr = 0; rr < 2; ++rr) {
            const int r = 2 * w + rr, g = r >> 2, tt = r & 3, h = 4 * kvh + g;
            const LAS float* q = Ql + r * 64;
            float l = 0.f;
#pragma unroll
            for (int k = 0; k < 3; ++k) { const int j = lane + 64 * k; float p = 0.f;
                const bool ok = (j < 128) ? (j >= tt + 1) : (j - 128 <= tt);
                if (j < 132 && ok) { const LAS float* kp = Kl + j * SS_KP; float dsum = 0.f;
#pragma unroll 16
                    for (int i = 0; i < 64; ++i) dsum += q[i] * kp[i];
                    p = __builtin_amdgcn_exp2f(dsum - bnd); }
                Pl[j] = p; l += p; }
            l = wave_sum(l) + __builtin_amdgcn_exp2f(C.sinks()[h] * LOG2E - bnd);
            asm volatile("s_waitcnt lgkmcnt(0)" ::: "memory");
            float acc = 0.f;
#pragma unroll 4
            for (int j = 0; j < 132; ++j) acc += Pl[j] * Vl[j * 64 + lane];
            O[(size_t)(TP + b * DS + tt) * 1024 + h * 64 + lane] = (bf16_t)f2bf(acc / l);
            asm volatile("s_waitcnt lgkmcnt(0)" ::: "memory");
        }
        __syncthreads();
    }
}
__device__ __forceinline__ void p_swa_attn(const Ctx& C) {
    const float bnd = C.p<float>(WS_BND)[1];
    { SwaRegs R; int u = blockIdx.x; const int nu = NB * NKV * 16;
      if (u < nu) { swa_load(C, u, R); swa_store(C, R); }
      __syncthreads();
      for (; u < nu; u += gridDim.x) { const int un = u + gridDim.x;
          if (un < nu) swa_load(C, un, R);
          swa_compute(C, u, bnd);
          __syncthreads();
          if (un < nu) swa_store(C, R);
          __syncthreads(); } }
    swa_sample(C, bnd);
}

constexpr int DC_CP = 528;
constexpr int DC_CIMG = 0, DC_CIMG_BYTES = 32 * DC_CP, DC_KPE_BYTES = 32 * 80, DC_IMG = DC_CIMG_BYTES + DC_KPE_BYTES, DC_KPE = DC_CIMG + DC_CIMG_BYTES;
constexpr int DC_PP = 80, DC_PIMG = DC_CIMG + 4 * DC_IMG, DC_PIMG_BYTES = 32 * DC_PP, DC_QC = DC_PIMG + 3 * DC_PIMG_BYTES, DC_PTAB = DC_QC + 8 * 6 * 2 * 4 * 16, DC_END = DC_PTAB + 128;
static_assert(DC_END <= MISC_OFF, "decode LDS map");
constexpr int DC_NSTEP = 128;
__device__ __forceinline__ int dec_cu_of(int pairIdx, int half) { return (pairIdx & 7) | (half << 3) | ((pairIdx >> 3) << 4); }
#define DC_BAR() asm volatile("s_waitcnt lgkmcnt(0)\n\ts_barrier" ::: "memory")
__device__ __forceinline__ void dec_A(const bf16x8 (&a)[2][16], bf16x8 (&bq)[4], const LAS unsigned char* cimg, int lane, f32x16& k0, f32x16& k1) {
    const LAS unsigned char* cb = cimg + (lane & 31) * DC_CP + (lane >> 5) * 16;
    k0 = zero16(); k1 = zero16();
#pragma unroll
    for (int s = 0; s < 16; ++s) {
        k0 = MFMA32(a[0][s], bq[s & 3], k0); k1 = MFMA32(a[1][s], bq[s & 3], k1);
        if (s + 4 < 16) bq[s & 3] = *(const LAS bf16x8*)(cb + (s + 4) * 32);
    }
}
__device__ __forceinline__ void dec_H2(const Ctx& C, const f32x16& k0, const f32x16& k1, const LAS unsigned char* kpe, LAS unsigned char* pimg, int w, int lane, float bnd) {
    const int l31 = lane & 31, hh = lane >> 5;
    const LAS unsigned char* qcb = C.lds + DC_QC + ((w * 12 + hh) * 4 + (l31 & 3)) * 16;
    const LAS unsigned char* kpb = kpe + l31 * 80 + hh * 16;
    float ss = 0.f;
#pragma unroll
    for (int r = 0; r < 16; ++r) ss += k0[r] * k0[r] + k1[r] * k1[r];
    ss += __shfl_xor(ss, 32);
    const float m = ss * (1.f / 64) + EPS, rn = rsqrtf(m), irn = m * rn;
    bf16x8 X[4];
    X[0] = pack8(k0[0], k0[1], k0[2], k0[3], k0[4], k0[5], k0[6], k0[7]); X[1] = pack8(k0[8], k0[9], k0[10], k0[11], k0[12], k0[13], k0[14], k0[15]);
    X[2] = pack8(k1[0], k1[1], k1[2], k1[3], k1[4], k1[5], k1[6], k1[7]); X[3] = pack8(k1[8], k1[9], k1[10], k1[11], k1[12], k1[13], k1[14], k1[15]);
    f32x16 S = zero16();
#pragma unroll
    for (int s = 4; s < 6; ++s) S = MFMA32(*(const LAS bf16x8*)(qcb + s * 128), *(const LAS bf16x8*)(kpb + (s - 4) * 32), S);
#pragma unroll
    for (int t = 0; t < 4; ++t) S[t] *= irn;
#pragma unroll
    for (int s = 0; s < 4; ++s) S = MFMA32(*(const LAS bf16x8*)(qcb + s * 128), X[s], S);
    if (lane < 32) {
        const unsigned p01 = pk2(__builtin_amdgcn_exp2f(S[0] * rn - bnd), __builtin_amdgcn_exp2f(S[1] * rn - bnd)), p23 = pk2(__builtin_amdgcn_exp2f(S[2] * rn - bnd), __builtin_amdgcn_exp2f(S[3] * rn - bnd));
        LAS bf16_t* pp = (LAS bf16_t*)(pimg + (4 * w) * DC_PP + lane * 2);
        pp[0] = (bf16_t)(p01 & 0xffffu); pp[DC_PP / 2] = (bf16_t)(p01 >> 16); pp[2 * (DC_PP / 2)] = (bf16_t)(p23 & 0xffffu); pp[3 * (DC_PP / 2)] = (bf16_t)(p23 >> 16);
    }
}
__device__ __forceinline__ const f32x4* dec_src(const Ctx& C, int s, int tid) {
    const int page = __builtin_amdgcn_readfirstlane(*(const LAS int*)(C.lds + DC_PTAB + (s >> 2) * 4));
    return (const f32x4*)(C.cache() + ((size_t)page * PAGE + 32 * (s & 3)) * DCKV) + tid;
}
__device__ __forceinline__ const f32x4* dec_src_pg(const Ctx& C, int pg, int s, int tid) {
    const int page = __builtin_amdgcn_readfirstlane(pg);
    return (const f32x4*)(C.cache() + ((size_t)page * PAGE + 32 * (s & 3)) * DCKV) + tid;
}
#define DEC_LOAD(v, src, w) do { v[0] = (src)[0]; v[1] = (src)[512]; v[2] = (src)[1024]; v[3] = (src)[1536]; if ((w) < 4) v[4] = (src)[2048]; asm volatile("" ::: "memory"); } while (0)
__device__ __forceinline__ void dec_put(const f32x4 (&v)[5], LAS unsigned char* img, int w, const int (&po)[5]) {
#pragma unroll
    for (int u = 0; u < 5; ++u) {
        if (u < 4 || w < 4) {
            const u32x2 o = {pk2(v[u][0], v[u][1]), pk2(v[u][2], v[u][3])};
            *(LAS u32x2*)(img + po[u]) = o; }
    }
}
__device__ __forceinline__ void p_mla_decode(const Ctx& C) {
    const int tid = C.tid, lane = C.lane, w = C.wave, l31 = lane & 31, hh = lane >> 5;
    const int cu = blockIdx.x; if (cu >= 256) return;
    const int half = (cu >> 3) & 1, pairIdx = (cu & 7) | ((cu >> 4) << 3), b = pairIdx >> 2, pgbase = (pairIdx & 3) * 32, h = 8 * half + w;
    const float bnd = C.p<float>(WS_BND)[0];
    const bf16_t* QF = C.p<bf16_t>(WS_QF); const bf16_t* WUKT = C.p<bf16_t>(WS_WUK);
    const int* ptab = C.page_table() + b * NPAGES + pgbase;
    const int key0 = tid / 72, c0 = tid % 72;
    int po[5];
    { int key = key0, c4 = c0;
#pragma unroll
      for (int u = 0; u < 5; ++u) { po[u] = c4 < 64 ? key * DC_CP + c4 * 8 : DC_CIMG_BYTES + key * 80 + (c4 - 64) * 8; c4 += 8; key += 7; if (c4 >= 72) { c4 -= 72; key += 1; } } }
    if (tid < 32) *(LAS int*)(C.lds + DC_PTAB + tid * 4) = ptab[tid];
    __syncthreads();
    const bool grpB = w >= 4;
    f32x4 v[5];
    { const f32x4* src = dec_src(C, 0, tid); DEC_LOAD(v, src, w); }
    for (int idx = tid; idx < 8 * 6 * 2 * 4; idx += NTHR) {
        const int t = idx & 3, h2 = (idx >> 2) & 1, s = (idx >> 3) % 6, hl = idx / 48;
        const bf16_t* q = QF + ((size_t)(TP + b * DS + t) * 16 + 8 * half + hl) * 96; float qv[8];
#pragma unroll
        for (int j = 0; j < 8; ++j) { if (s < 4) { const int dim = 16 * s + 8 * (j >> 2) + 4 * h2 + (j & 3); qv[j] = bf2f(q[dim]) * C.g_kn()[dim]; } else qv[j] = bf2f(q[64 + 16 * (s - 4) + 8 * h2 + j]); }
        *(LAS bf16x8*)(C.lds + DC_QC + idx * 16) = pack8(qv[0], qv[1], qv[2], qv[3], qv[4], qv[5], qv[6], qv[7]);
    }
    for (int i = tid; i < 2 * DC_IMG / 16; i += NTHR) *(LAS u32x4*)(C.lds + DC_CIMG + 2 * DC_IMG + i * 16) = (u32x4){0u, 0u, 0u, 0u};
    for (int i = tid; i < 2 * DC_PIMG_BYTES / 4; i += NTHR) *(LAS unsigned*)(C.lds + DC_PIMG + DC_PIMG_BYTES + i * 4) = 0u;
    dec_put(v, C.lds + DC_CIMG, w, po);
    { const f32x4* src = dec_src(C, 1, tid); DEC_LOAD(v, src, w); }
    if (grpB) {
        dec_put(v, C.lds + DC_CIMG + DC_IMG, w, po);
        asm volatile("" ::: "memory");
        const f32x4* src = dec_src(C, 2, tid); DEC_LOAD(v, src, w);
    }
    bf16x8 a[2][16];
#pragma unroll
    for (int dt = 0; dt < 2; ++dt)
#pragma unroll
        for (int s = 0; s < 16; ++s) a[dt][s] = *(const bf16x8*)(WUKT + (size_t)(256 * (h >> 2) + 128 * dt + 32 * (h & 3) + l31) * 256 + 16 * s + 8 * hh);
    f32x16 acc = zero16(); float lrow = 0.f;
    __builtin_amdgcn_s_waitcnt(0x0F70);
    DC_BAR();
    const int trq = (8 * hh + ((lane & 15) >> 2)) * DC_CP + (32 * w + 16 * ((lane >> 4) & 1) + 4 * (lane & 3)) * 2;
    static_assert(4 * DC_CP == 2112 && 16 * DC_CP == 8448 && 20 * DC_CP == 10560, "tr-read offsets");
#define DEC_PV(T_IMG, T_P) do { \
        const LAS unsigned char* pprev_ = C.lds + DC_PIMG + (T_P) * DC_PIMG_BYTES; \
        const unsigned taddr_ = (unsigned)(unsigned long)(C.lds + DC_CIMG + (T_IMG) * DC_IMG + trq); \
        v4i16_t b00, b01, b10, b11; \
        asm volatile("ds_read_b64_tr_b16 %0, %4\n\tds_read_b64_tr_b16 %1, %4 offset:2112\n\tds_read_b64_tr_b16 %2, %4 offset:8448\n\tds_read_b64_tr_b16 %3, %4 offset:10560" \
                     : "=&v"(b00), "=&v"(b01), "=&v"(b10), "=&v"(b11) : "v"(taddr_) : "memory"); \
        const unsigned x0_ = *(const LAS unsigned*)(pprev_ + (4 * w + (lane >> 4)) * DC_PP + (lane & 15) * 4); \
        const bf16x8 pa0_ = *(const LAS bf16x8*)(pprev_ + l31 * DC_PP + hh * 16), pa1_ = *(const LAS bf16x8*)(pprev_ + l31 * DC_PP + hh * 16 + 32); \
        DEC_PV_EXTRA \
        lrow += bflo(x0_) + bfhi(x0_); \
        { const bf16x8 bb = {b00[0], b00[1], b00[2], b00[3], b01[0], b01[1], b01[2], b01[3]}; acc = MFMA32(pa0_, bb, acc); } \
        { const bf16x8 bb = {b10[0], b10[1], b10[2], b10[3], b11[0], b11[1], b11[2], b11[3]}; acc = MFMA32(pa1_, bb, acc); } } while (0)
    int p3 = 0;
#pragma unroll 1
    for (int s = 0; s < DC_NSTEP; ++s) {
        const LAS unsigned char* cimg = C.lds + DC_CIMG + (s & 3) * DC_IMG; const LAS unsigned char* kpe = cimg + DC_CIMG_BYTES;
        const int pm2 = p3 == 2 ? 0 : p3 + 1;
        bf16x8 bq[4]; f32x16 k0, k1;
        const int xn = s + 2 + (grpB ? 1 : 0);
        const int pgn = *(const LAS int*)(C.lds + DC_PTAB + ((xn >> 2) & 31) * 4);
#define DEC_PV_EXTRA { const LAS unsigned char* cb_ = cimg + l31 * DC_CP + hh * 16; bq[0] = *(const LAS bf16x8*)cb_; bq[1] = *(const LAS bf16x8*)(cb_ + 32); bq[2] = *(const LAS bf16x8*)(cb_ + 64); bq[3] = *(const LAS bf16x8*)(cb_ + 96); }
        DEC_PV((s + 2) & 3, pm2);
#undef DEC_PV_EXTRA
        dec_A(a, bq, cimg, lane, k0, k1);
        if (grpB) DC_BAR();
        __builtin_amdgcn_s_setprio(3);
        dec_H2(C, k0, k1, kpe, C.lds + DC_PIMG + p3 * DC_PIMG_BYTES, w, lane, bnd);
        { const int x = s + 1 + (grpB ? 1 : 0);
          if (x < DC_NSTEP) {
            dec_put(v, C.lds + DC_CIMG + (x & 3) * DC_IMG, w, po);
            asm volatile("" ::: "memory");
            if (x + 1 < DC_NSTEP) { const f32x4* src = dec_src_pg(C, pgn, x + 1, tid); DEC_LOAD(v, src, w); }
          } }
        __builtin_amdgcn_s_setprio(0);
        if (!grpB) DC_BAR();
        p3 = pm2;
    }
    DC_BAR();
#define DEC_PV_EXTRA
    DEC_PV((DC_NSTEP - 2) & 3, (DC_NSTEP - 2) % 3);
    DEC_PV((DC_NSTEP - 1) & 3, (DC_NSTEP - 1) % 3);
#undef DEC_PV_EXTRA
#undef DEC_PV
    float* PART = C.p<float>(WS_PART) + (size_t)cu * 32 * 256; float* PARTL = C.p<float>(WS_PARTL) + cu * 32;
    { int l2 = lane; asm volatile("" : "+v"(l2)); const int e31 = l2 & 31, eh = l2 >> 5;
#pragma unroll
    for (int r = 0; r < 16; ++r) PART[((r & 3) + 8 * (r >> 2) + 4 * eh) * 256 + 32 * w + e31] = acc[r]; }
    lrow += __shfl_xor(lrow, 1); lrow += __shfl_xor(lrow, 2); lrow += __shfl_xor(lrow, 4); lrow += __shfl_xor(lrow, 8);
    if ((lane & 15) == 0) PARTL[4 * w + (lane >> 4)] = lrow;
    __syncthreads();
}
__device__ __forceinline__ void p_mla_decode_fin(const Ctx& C) {
    const float bnd = C.p<float>(WS_BND)[0]; const int lane = C.lane, w = C.wave, qd = w & 3;
    const bf16_t* QF = C.p<bf16_t>(WS_QF); const bf16_t* KN = C.p<bf16_t>(WS_KN); const bf16_t* KPE = C.p<bf16_t>(WS_KPE); bf16_t* O = C.p<bf16_t>(WS_O);
    const float* PART = C.p<float>(WS_PART); const float* PARTL = C.p<float>(WS_PARTL); const float* ROWS = C.out + (size_t)T * DM;
    LAS float* red = (LAS float*)C.lds;
    for (int task0 = 2 * blockIdx.x; task0 < DB * HA; task0 += 2 * gridDim.x) {
        const int task = task0 + (w >> 2), h = task & 15, b = task >> 4, c = 64 * qd + lane;
        float latv[4];
#pragma unroll
        for (int t = 0; t < 4; ++t) {
            const int rho = 4 * (h & 7) + t, tok = TP + b * DS + t;
            float acc = 0.f, l = 0.f;
#pragma unroll
            for (int k = 0; k < 4; ++k) { const int cu = dec_cu_of(4 * b + k, h >> 3); acc += PART[((size_t)cu * 32 + rho) * 256 + c]; l += PARTL[cu * 32 + rho]; }
            const bf16_t* q = QF + ((size_t)tok * 16 + h) * 96;
            const float q0 = bf2f(q[lane]), q1 = lane < 32 ? bf2f(q[64 + lane]) : 0.f;
            for (int j = 0; j <= t; ++j) { const int tk = TP + b * DS + j;
                float dd = q0 * bf2f(KN[(size_t)tk * 1024 + h * 64 + lane]) + (lane < 32 ? q1 * bf2f(KPE[(size_t)tk * 32 + lane]) : 0.f);
                dd = wave_sum(dd); const float p = __builtin_amdgcn_exp2f(dd - bnd); l += p;
                acc += p * ROWS[(size_t)tk * DCKV + c]; }
            latv[t] = acc / l;
        }
        float o0 = 0.f, o1 = 0.f, o2 = 0.f, o3 = 0.f;
        const float* wp = C.w_uv() + (size_t)(64 * qd) * 1024 + h * 64 + lane;
#pragma unroll
        for (int cc = 0; cc < 64; ++cc) { const float wv = wp[(size_t)cc * 1024];
            o0 += __builtin_bit_cast(float, __builtin_amdgcn_readlane(__builtin_bit_cast(int, latv[0]), cc)) * wv; o1 += __builtin_bit_cast(float, __builtin_amdgcn_readlane(__builtin_bit_cast(int, latv[1]), cc)) * wv;
            o2 += __builtin_bit_cast(float, __builtin_amdgcn_readlane(__builtin_bit_cast(int, latv[2]), cc)) * wv; o3 += __builtin_bit_cast(float, __builtin_amdgcn_readlane(__builtin_bit_cast(int, latv[3]), cc)) * wv; }
        red[(w * 4 + 0) * 64 + lane] = o0; red[(w * 4 + 1) * 64 + lane] = o1; red[(w * 4 + 2) * 64 + lane] = o2; red[(w * 4 + 3) * 64 + lane] = o3;
        __syncthreads();
        { const int wb = w & 4; float s = 0.f;
#pragma unroll
          for (int k = 0; k < 4; ++k) s += red[((wb + k) * 4 + qd) * 64 + lane];
          O[(size_t)(TP + b * DS + qd) * 1024 + h * 64 + lane] = (bf16_t)f2bf(s); }
        __syncthreads();
    }
}
}
namespace mk {
constexpr int NPHASE = 19;
__global__ void __launch_bounds__(NTHR, 2) mk_fwd(Args a) {
    extern __shared__ __attribute__((aligned(16))) unsigned char lds_raw[];
    Ctx C{(LAS unsigned char*)lds_raw, (int)threadIdx.x, (int)(threadIdx.x & 63), __builtin_amdgcn_readfirstlane((int)(threadIdx.x >> 6)), 0, 0, a.ws, a.out, a};
    C.gw = blockIdx.x * NWAVES + C.wave; C.ngw = gridDim.x * NWAVES;
    volatile LAS unsigned* misc = (volatile LAS unsigned*)(C.lds + MISC_OFF);
    if (C.tid < 32) misc[C.tid] = 0u;
    __syncthreads();
    XcdBarrier bar = xcd_barrier_post((unsigned*)(a.ws + WS_CTL) + CW_BAR + a.li * XCD_BAR_WORDS, misc + 8);
    if (a.never) cg::this_grid().sync();
    const int lo = a.ph_lo, hi = a.ph_hi;
#ifndef PH_MASK
#define PH_MASK 0xFFFFFFu
#endif
#define IN(k) ((((PH_MASK) >> (k)) & 1u) && lo <= (k) && (k) < hi)
#ifndef REP_MASK
#define REP_MASK 0u
#endif
#define REFRESH() do { C.lane = lane_id_fresh(); C.tid = C.wave * 64 + C.lane; } while (0)
#define PH(k, ...) if (IN(k)) { REFRESH(); __VA_ARGS__ } if (IN(k) && ((((REP_MASK) >> (k)) & 1u) != 0u)) { REFRESH(); __VA_ARGS__ }
#define SEAM(k) do { if (IN(k) && (k) + 1 < hi) xcd_barrier(bar); } while (0)
#define HB C.p<bf16_t>(WS_HB)
#define ACT C.p<bf16_t>(WS_ACT)
#define O C.p<bf16_t>(WS_O)

#define XS (C.x_sample() - (size_t)TP * DM)
#ifndef REP_ATTN
#define REP_ATTN 1
#endif
#define SS1 C.p<float>(WS_SS)
#define SS2 (C.p<float>(WS_SS) + T)
#define SS3 (C.p<float>(WS_SS) + 2 * T)
    PH(0,  p0_prologue(C); p_norm_x(C); ) SEAM(0);
    PH(1,  const float* cosA = C.p<float>(WS_ROPE); FPostA f{C.p<bf16_t>(WS_CQ), C.p<bf16_t>(WS_CKV), C.p<bf16_t>(WS_KPE), C.p<float>(WS_SS) + 3 * T, C.p<float>(WS_SS) + 4 * T, C.out + (size_t)T * DM, C.g_qc(), C.g_ckv(), C.g_kr(), cosA, cosA + NPOS * 16};
        big_gemm(C.lds, HB, C.p<bf16_t>(WS_WAIN), TP, 768, 1024, f, C.wave); skinny_gemm(C.lds, HB, C.p<bf16_t>(WS_WAIN), 768, 1024, f, C.wave, C.lane, 192); ) SEAM(1);
    PH(3,
        if (!(a.flags & 16384)) { FMlaQN f{C.p<bf16_t>(WS_QF), C.g_qn(), C.p<float>(WS_SS) + 3 * T};
          big_gemm(C.lds, C.p<bf16_t>(WS_CQ), C.p<bf16_t>(WS_WUQ), TP, 1024, 384, f, C.wave); skinny_gemm(C.lds, C.p<bf16_t>(WS_CQ), C.p<bf16_t>(WS_WUQ), 1024, 384, f, C.wave, C.lane); }
        if (!(a.flags & 32768)) { const float* cosA = C.p<float>(WS_ROPE); FMlaQR f{C.p<bf16_t>(WS_QF), C.g_qr(), cosA, cosA + NPOS * 16, C.p<float>(WS_SS) + 3 * T};
          big_gemm(C.lds, C.p<bf16_t>(WS_CQ), C.p<bf16_t>(WS_WUQ) + (size_t)1024 * 384, TP, 512, 384, f, C.wave);
          skinny_gemm(C.lds, C.p<bf16_t>(WS_CQ), C.p<bf16_t>(WS_WUQ) + (size_t)1024 * 384, 512, 384, f, C.wave, C.lane, 128); }
        if (!(a.flags & 65536)) { FKnV f{C.p<bf16_t>(WS_KN), C.p<bf16_t>(WS_KNRAW), C.g_kn(), C.p<float>(WS_SS) + 4 * T}; big_gemm(C.lds, C.p<bf16_t>(WS_CKV), C.p<bf16_t>(WS_WUK), TP, 2048, 256, f, C.wave); skinny_gemm(C.lds, C.p<bf16_t>(WS_CKV), C.p<bf16_t>(WS_WUK), 1024, 256, f, C.wave, C.lane); }
        if (!(a.flags & 131072)) p_rows_out(C);
    ) SEAM(3);
    PH(5,  if (!(a.flags & 256)) { p_mla_attn_prompt(C); if (REP_ATTN > 1) p_mla_attn_prompt(C); }
           if (!(a.flags & 512)) p_mla_decode(C); ) SEAM(5);
    PH(6,  p_mla_decode_fin(C); ) SEAM(6);
    PH(7,  { FResid<0, false> f{nullptr, C.x_prompt(), HB, SS1}; big_gemm(C.lds, O, C.p<bf16_t>(WS_WAOUT), TP, 1024, 1024, f, C.wave); }
           { FResid<0, false> f{nullptr, XS, HB, SS1}; skinny_gemm(C.lds, O, C.p<bf16_t>(WS_WAOUT), 1024, 1024, f, C.wave, C.lane); } ) SEAM(7);
    PH(9,  FSwiglu f{ACT, SS1}; big_gemm(C.lds, HB, C.p<bf16_t>(WS_WFIN0), TP, 5632, 1024, f, C.wave); skinny_gemm(C.lds, HB, C.p<bf16_t>(WS_WFIN0), 5632, 1024, f, C.wave, C.lane, 128); ) SEAM(9);
    PH(10, FResid<1, false> f{nullptr, nullptr, HB, SS2}; big_gemm(C.lds, ACT, C.p<bf16_t>(WS_WFOUT0), TP, 1024, 2816, f, C.wave); skinny_gemm(C.lds, ACT, C.p<bf16_t>(WS_WFOUT0), 1024, 2816, f, C.wave, C.lane); ) SEAM(10);
    PH(12, { const float* cosB = C.p<float>(WS_ROPE) + NPOS * 32; FKvq f{C.p<bf16_t>(WS_KS), C.p<bf16_t>(WS_VS), C.p<bf16_t>(WS_QBF), SS2, C.g_k_b(), C.g_q_b(), cosB, cosB + NPOS * 8, C.out}; big_gemm(C.lds, HB, C.p<bf16_t>(WS_WKVQ), TP, 1536, 1024, f, C.wave); skinny_gemm(C.lds, HB, C.p<bf16_t>(WS_WKVQ), 1536, 1024, f, C.wave, C.lane, 128); }
 ) SEAM(12);
    PH(14, p_swa_attn(C); ) SEAM(14);
    PH(15, FResid<1, false> f{nullptr, nullptr, HB, SS3}; big_gemm(C.lds, O, C.p<bf16_t>(WS_WBOUT), TP, 1024, 1024, f, C.wave); skinny_gemm(C.lds, O, C.p<bf16_t>(WS_WBOUT), 1024, 1024, f, C.wave, C.lane); ) SEAM(15);
    PH(17, FSwiglu f{ACT, SS3}; big_gemm(C.lds, HB, C.p<bf16_t>(WS_WFIN1), TP, 5632, 1024, f, C.wave); skinny_gemm(C.lds, HB, C.p<bf16_t>(WS_WFIN1), 5632, 1024, f, C.wave, C.lane, 128); ) SEAM(17);
    PH(18, FResid<1, true> f{C.out, nullptr, HB, nullptr}; big_gemm(C.lds, ACT, C.p<bf16_t>(WS_WFOUT1), TP, 1024, 2816, f, C.wave); skinny_gemm(C.lds, ACT, C.p<bf16_t>(WS_WFOUT1), 1024, 2816, f, C.wave, C.lane); )
#undef IN
#undef HB
#undef ACT
#undef O
#undef SS1
#undef SS2
#undef SS3
#undef XS
#undef SEAM
}
static int g_grid = 0;
static void launch_phases(void* const* d_in, void* d_out, void* d_ws, hipStream_t stream, int lo, int hi, int li, int flags = 0) {
    if (g_grid == 0) {
        int dev = 0, cus = 0, per_cu = 0;
        (void)hipGetDevice(&dev); (void)hipDeviceGetAttribute(&cus, hipDeviceAttributeMultiprocessorCount, dev);
        (void)hipFuncSetAttribute((const void*)mk_fwd, hipFuncAttributeMaxDynamicSharedMemorySize, LDS_BYTES);
        (void)hipOccupancyMaxActiveBlocksPerMultiprocessor(&per_cu, (const void*)mk_fwd, NTHR, LDS_BYTES);
        (void)hipGetLastError();
        g_grid = cus * (per_cu >= 1 ? 1 : 0); if (g_grid > 256) g_grid = 256;
        if (g_grid != 256) fprintf(stderr, "kernel_launch: grid %d (cus %d per_cu %d): this kernel is written for 256 CUs\n", g_grid, cus, per_cu);
    }
    Args a{};
    for (int i = 0; i < 28; ++i) a.in[i] = d_in[i];
    a.out = (float*)d_out; a.ws = (unsigned char*)d_ws; a.ph_lo = lo; a.ph_hi = hi; a.li = li; a.never = 0; a.flags = flags;
    void* args[] = {&a};
    hipError_t e = hipLaunchCooperativeKernel((const void*)mk_fwd, dim3(g_grid), dim3(NTHR), args, LDS_BYTES, stream);
    if (e != hipSuccess) fprintf(stderr, "kernel_launch: cooperative launch failed: %s (grid %d)\n", hipGetErrorString(e), g_grid);
}
}
#ifndef MK_DEBUG
#define MK_DEBUG 0
#endif
#if MK_DEBUG
__global__ void k_bf16_to_f32(const bf16_t* in, float* out, size_t n, float scale) {
    size_t i = (size_t)blockIdx.x * blockDim.x + threadIdx.x; if (i < n) out[i] = __builtin_bit_cast(float, (unsigned)in[i] << 16) * scale; }
__global__ void k_copy_f32(const float* in, float* out, size_t n) { size_t i = (size_t)blockIdx.x * blockDim.x + threadIdx.x; if (i < n) out[i] = in[i]; }
__global__ void k_vt_to_v(const bf16_t* vt, float* V) { size_t i = (size_t)blockIdx.x * blockDim.x + threadIdx.x; if (i >= (size_t)mk::TP * 1024) return;
    size_t t = i / 1024, c = i % 1024; V[i] = __builtin_bit_cast(float, (unsigned)vt[c * mk::TP + t] << 16); }
static void cvt(hipStream_t st, const bf16_t* in, float* out, size_t n, float scale = 1.f) { hipLaunchKernelGGL(k_bf16_to_f32, dim3((unsigned)((n + 255) / 256)), dim3(256), 0, st, in, out, n, scale); }
#endif
extern "C" void kernel_launch(void* const* d_in, const int* in_sizes, int n_in, void* d_out, int out_size, void* d_ws, size_t ws_size, hipStream_t stream) {
    (void)in_sizes; (void)n_in; (void)out_size; (void)ws_size;
    (void)hipMemsetAsync((char*)d_ws + mk::WS_CTL, 0, mk::CTL_ZERO_BYTES, stream);
#if MK_DEBUG == 0
    mk::launch_phases(d_in, d_out, d_ws, stream, 0, mk::NPHASE, 0);
#else
    unsigned char* ws = (unsigned char*)d_ws; void* nvws = ws + ((size_t)1536 << 20);
    using namespace mk;
#if MK_DEBUG == 1
    nv::nv_run(d_in, d_out, nvws, stream, 2);
    launch_phases(d_in, d_out, d_ws, stream, 0, 3, 0);
#elif MK_DEBUG == 2
    nv::nv_run(d_in, d_out, nvws, stream, 0);
    launch_phases(d_in, d_out, d_ws, stream, 0, 5, 0);
    cvt(stream, (const bf16_t*)(ws + WS_QF), nv::g_nv.Q, (size_t)T * 1536, 1.f / (SCALE_A * LOG2E));
    cvt(stream, (const bf16_t*)(ws + WS_KN), nv::g_nv.KN, (size_t)T * 1024);
    hipLaunchKernelGGL(k_vt_to_v, dim3(TP * 1024 / 256), dim3(256), 0, stream, (const bf16_t*)(ws + WS_VT), nv::g_nv.V);
    nv::nv_attn_only(d_in, nvws, stream);
    nv::nv_run(d_in, d_out, nvws, stream, 1);
#elif MK_DEBUG == 3
    nv::nv_run(d_in, d_out, nvws, stream, 0);
    launch_phases(d_in, d_out, d_ws, stream, 0, 7, 0);
    cvt(stream, (const bf16_t*)(ws + WS_O), nv::g_nv.O, (size_t)T * 1024);
    nv::nv_run(d_in, d_out, nvws, stream, 1);
#elif MK_DEBUG == 4
    nv::nv_run(d_in, d_out, nvws, stream, 2);
    launch_phases(d_in, d_out, d_ws, stream, 0, 14, 0);
#elif MK_DEBUG == 6
    nv::nv_run(d_in, d_out, nvws, stream, 2);
#ifndef EXP_PHASE
#define EXP_PHASE 5
#endif
    launch_phases(d_in, d_out, d_ws, stream, 0, EXP_PHASE, 0);
#ifndef EXP_REPS
#define EXP_REPS 10
#endif
#ifndef EXP_FLAGS
#define EXP_FLAGS 0
#endif
    for (int r = 0; r < EXP_REPS; ++r) launch_phases(d_in, d_out, d_ws, stream, EXP_PHASE, EXP_PHASE + 1, 1 + r, EXP_FLAGS);
#elif MK_DEBUG == 5
    nv::nv_run(d_in, d_out, nvws, stream, 2);
    launch_phases(d_in, d_out, d_ws, stream, 0, NPHASE, 0);
#endif
#endif
}
```

```cpp
#include <hip/hip_runtime.h>
#include <hip/hip_cooperative_groups.h>
#include <cstdio>
#include <cstdint>
#include <cmath>
namespace cg = cooperative_groups;
#define LAS __attribute__((address_space(3)))
typedef unsigned short bf16_t;
typedef short bf16x8 __attribute__((ext_vector_type(8)));
typedef float f32x4 __attribute__((ext_vector_type(4)));
typedef float f32x16 __attribute__((ext_vector_type(16)));
typedef unsigned u32x2 __attribute__((ext_vector_type(2)));
typedef unsigned u32x4 __attribute__((ext_vector_type(4)));

namespace mk {
constexpr int DM = 1024, NB = 8, SEQ = 2048, DB = 32, DS = 4, PAST = 16384, PAGE = 128, NPAGES = 128;
constexpr int TP = NB * SEQ, TS = DB * DS, T = TP + TS;
constexpr int HA = 16, DQC = 384, DC = 256, DCKV = 288, DQH = 96;
constexpr int HB = 16, NKV = 4, WIN = 128, DFF = 2816;
constexpr float EPS = 1e-6f;
constexpr int NPOS = SEQ + DS;
constexpr float LOG2E = 1.4426950408889634f;
constexpr float SCALE_A = 0.10206207261596575f, SCALE_B = 0.125f;
constexpr int NWAVES = 8, NTHR = 512;

__device__ __forceinline__ unsigned f2bf(float f) { unsigned u = __builtin_bit_cast(unsigned, f); return (u + 0x7fffu + ((u >> 16) & 1u)) >> 16; }
typedef float f32x2_t __attribute__((ext_vector_type(2))); typedef __bf16 bf16x2_t __attribute__((ext_vector_type(2)));
__device__ __forceinline__ unsigned pk2(float lo, float hi) { const f32x2_t v = {lo, hi}; const bf16x2_t b = __builtin_convertvector(v, bf16x2_t); return __builtin_bit_cast(unsigned, b); }
__device__ __forceinline__ float bf2f(unsigned b) { return __builtin_bit_cast(float, b << 16); }
__device__ __forceinline__ float bflo(unsigned w) { return __builtin_bit_cast(float, w << 16); }
__device__ __forceinline__ float bfhi(unsigned w) { return __builtin_bit_cast(float, w & 0xffff0000u); }
__device__ __forceinline__ float wave_sum(float v) {
#pragma unroll
    for (int o = 1; o < 64; o <<= 1) v += __shfl_xor(v, o);
    return v;
}
__device__ __forceinline__ int lane_id_fresh() { int l; asm volatile("v_mbcnt_lo_u32_b32 %0, -1, 0\n\tv_mbcnt_hi_u32_b32 %0, -1, %0" : "=v"(l)); return l; }
__device__ __forceinline__ int tok_pidx(int t) { return t < TP ? (t % SEQ) : (SEQ + (t - TP) % DS); }

#define XB_TMO      128
#define XB_XCNT(j)  (256  + 64 * (j))
#define XB_XSUB(j)  (1280 + 64 * (j))
#define XB_XGEN(j)  (2304 + 64 * (j))
#define XB_TOP      3328
#define XB_TOPGEN   3392
#define XCD_BAR_WORDS 3456
#define XB_SPIN_CAP (1u << 18)
__device__ __forceinline__ unsigned xb_ld(unsigned* p)              { return __hip_atomic_load(p, __ATOMIC_RELAXED, __HIP_MEMORY_SCOPE_AGENT); }
__device__ __forceinline__ unsigned xb_add(unsigned* p, unsigned v) { return __hip_atomic_fetch_add(p, v, __ATOMIC_RELAXED, __HIP_MEMORY_SCOPE_AGENT); }
__device__ __forceinline__ unsigned xb_xcc_id() { return (unsigned)__builtin_amdgcn_s_getreg((3 << 11) | 20) & 0xFu; }
#define XB_SPIN(cond, bar) do { unsigned _sp = 0; while (cond) { __builtin_amdgcn_s_sleep(1); \
    if ((++_sp & 255u) == 0u) { if (xb_ld(&(bar)[XB_TMO])) break; if (_sp > XB_SPIN_CAP) { atomicAdd(&(bar)[XB_TMO], 1u); break; } } } } while (0)
struct XcdBarrier { unsigned* bar; unsigned x; volatile LAS unsigned* st; };
__device__ __forceinline__ XcdBarrier xcd_barrier_post(unsigned* bar, volatile LAS unsigned* st) {
    XcdBarrier b; b.bar = bar; b.x = xb_xcc_id(); b.st = st;
    if (threadIdx.x == 0) (void)xb_add(&bar[XB_XCNT(b.x)], 1u);
    return b;
}
__device__ __forceinline__ void xcd_barrier_complete(unsigned* bar, unsigned x, unsigned& nloc, unsigned& nx) {
    const unsigned G = gridDim.x * gridDim.y * gridDim.z;
    unsigned sum, cnt, mine, sp = 0u;
    for (;;) {
        sum = 0u; cnt = 0u; mine = 0u;
#pragma unroll
        for (unsigned j = 0; j < 16; ++j) { const unsigned c = xb_ld(&bar[XB_XCNT(j)]); sum += c; cnt += (c > 0u) ? 1u : 0u; mine = (j == x) ? c : mine; }
        if (sum == G) break;
        __builtin_amdgcn_s_sleep(1);
        if ((++sp & 255u) == 0u) { if (xb_ld(&bar[XB_TMO])) break; if (sp > XB_SPIN_CAP) { atomicAdd(&bar[XB_TMO], 1u); break; } }
    }
    nloc = mine > 0u ? mine : 1u; nx = cnt > 0u ? cnt : 1u;
}
__device__ __forceinline__ void xcd_barrier(const XcdBarrier& b) {
    asm volatile("s_waitcnt vmcnt(0)" ::: "memory");
    __syncthreads();
    if (threadIdx.x == 0) {
        unsigned* bar = b.bar;
        __builtin_amdgcn_s_waitcnt(0);
        unsigned nloc = b.st[0], nx = b.st[1];
        if (nloc == 0u) { xcd_barrier_complete(bar, b.x, nloc, nx); b.st[0] = nloc; b.st[1] = nx; }
        const unsigned old = xb_add(&bar[XB_XSUB(b.x)], 1u);
        const unsigned gen = old / nloc;
        if (old + 1u == (gen + 1u) * nloc) {
            __builtin_amdgcn_fence(__ATOMIC_RELEASE, "agent");
            asm volatile("s_waitcnt vmcnt(0)" ::: "memory");
            const unsigned og = xb_add(&bar[XB_TOP], 1u);
            const unsigned tg = og / nx;
            if (og + 1u == (tg + 1u) * nx) xb_add(&bar[XB_TOPGEN], 1u);
            else XB_SPIN(xb_ld(&bar[XB_TOPGEN]) == tg, bar);
            __builtin_amdgcn_fence(__ATOMIC_ACQUIRE, "agent");
            xb_add(&bar[XB_XGEN(b.x)], 1u);
            asm volatile("s_waitcnt vmcnt(0)" ::: "memory");
        } else {
            XB_SPIN(xb_ld(&bar[XB_XGEN(b.x)]) == gen, bar);
            __builtin_amdgcn_fence(__ATOMIC_ACQUIRE, "agent");
            asm volatile("s_waitcnt vmcnt(0)" ::: "memory");
        }
    }
    __syncthreads();
}
}
namespace pg8 {
#define PG8_LAS __attribute__((address_space(3)))
constexpr int BM = 256, BK = 64, HALF = 128, HTB = HALF * BK * 2, STAGE_BYTES = 8 * HTB, NXCD = 8, WGM = 8;
__host__ __device__ __forceinline__ int lds_byte(int r, int c) { const int st = (r >> 4) * 2 + (c >> 5), rr = r & 15, cc = c & 31, ob = rr * 64 + cc * 2; return st * 1024 + (ob ^ (((ob >> 9) & 1) << 5)); }
__host__ __device__ __forceinline__ void stage_rc(int b, int& R, int& C) { const int st = b / 1024, sb = b % 1024, swz = sb ^ (((sb >> 9) & 1) << 5); R = (st >> 1) * 16 + swz / 64; C = (st & 1) * 32 + (swz % 64) / 2; }
__host__ __device__ __forceinline__ int perm32(int rho) { const int n = rho >> 4, i = rho & 15; return 8 * (i >> 2) + 4 * n + (i & 3); }

struct Unit { int pm, pn; };
struct Gemm { const bf16_t* A; const bf16_t* Bt; int M, N, K; };

struct StaticOrder {
    int nM, nN, nwg, G, c;
    __host__ __device__ void init(int M, int N, int G_, int c_) { nM = M / BM; nN = N / BM; nwg = nM * nN; G = G_; c = c_; }
    __host__ __device__ bool next(int i, Unit& u) const {
        const long L = (long)i * G + c; if (L >= nwg) return false;
        int wgid = (int)L; { const int q = nwg / NXCD, r = nwg % NXCD, xcd = wgid % NXCD, off = wgid / NXCD; wgid = (xcd < r ? xcd * (q + 1) : r * (q + 1) + (xcd - r) * q) + off; }
        const int nig = WGM * nN, gid = wgid / nig, fm = gid * WGM, gsz = (nM - fm) < WGM ? (nM - fm) : WGM;
        u.pm = fm + ((wgid % nig) % gsz); u.pn = (wgid % nig) / gsz; return true;
    }
    __device__ __forceinline__ void a_ready(const Unit&) const {}
    __device__ __forceinline__ void done(const Unit&) const {}
};
template <class Epi, class Sched, bool ALIGN_EPI = false, bool SP2 = false>
__device__ __forceinline__ void gemm_phase(PG8_LAS unsigned char* lds, const Gemm g, const Sched& S, const Epi& E, const int wave_id) {
    const int lane = mk::lane_id_fresh(), wid = wave_id, tid = wid * 64 + lane,     wr = wid >> 2, wc = wid & 3, fr = lane & 15, fq = lane >> 4;
    const int K = g.K, nt = K / BK;
    unsigned voffA[2], voffB[2];
#pragma unroll
    for (int i = 0; i < 2; ++i) { int R, C; stage_rc(tid * 16 + i * 8192, R, C); const int Rb = Epi::PERM ? ((R & ~31) + perm32(R & 31)) : R;
        voffA[i] = (unsigned)(R * K + C) * 2u; voffB[i] = (unsigned)(Rb * K + C) * 2u; }
    const size_t kstep = (size_t)(BK * 2);
    const size_t hstep = (size_t)HALF * K * 2;
    const size_t tstep = 2 * hstep;
    const unsigned ldsw = (unsigned)wid * 1024u;
    const int aoff = lds_byte(wr * 64 + fr, fq * 8), boff = lds_byte(wc * 32 + fr, fq * 8);
#define PG8_SA(b, h) (((b) * 2 + (h)) * HTB)
#define PG8_SB(b, h) ((4 + (b) * 2 + (h)) * HTB)
#define PG8_STAGE(bufoff, gbase, voff) do { _Pragma("unroll") for (int _i = 0; _i < 2; ++_i) \
        __builtin_amdgcn_global_load_lds((const unsigned*)((const char*)(gbase) + (voff)[_i]), (PG8_LAS unsigned*)(lds + (bufoff) + ldsw + _i * 8192), 16, 0, 0); } while (0)
#define PG8_LDA(dst, b, h) do { _Pragma("unroll") for (int m = 0; m < 4; ++m) _Pragma("unroll") for (int k = 0; k < 2; ++k) dst[m][k] = *(const PG8_LAS bf16x8*)(lds + PG8_SA(b, h) + aoff + m * 2048 + k * 1024); } while (0)
#define PG8_LDB(dst, b, h) do { _Pragma("unroll") for (int n = 0; n < 2; ++n) _Pragma("unroll") for (int k = 0; k < 2; ++k) dst[n][k] = *(const PG8_LAS bf16x8*)(lds + PG8_SB(b, h) + boff + n * 2048 + k * 1024); } while (0)
#define PG8_MMA(ai, bj, At, Bt) do { __builtin_amdgcn_s_setprio(1); _Pragma("unroll") for (int m = 0; m < 4; ++m) _Pragma("unroll") for (int n = 0; n < 2; ++n) _Pragma("unroll") for (int k = 0; k < 2; ++k) \
        acc[ai][bj][m][n] = __builtin_amdgcn_mfma_f32_16x16x32_bf16(Bt[n][k], At[m][k], acc[ai][bj][m][n], 0, 0, 0); __builtin_amdgcn_s_setprio(0); } while (0)
#define PG8_WAIT_V(n) asm volatile("s_waitcnt vmcnt(" #n ")" ::: "memory")
#define PG8_WAIT_L(n) asm volatile("s_waitcnt lgkmcnt(" #n ")" ::: "memory")
#define PG8_BAR __builtin_amdgcn_s_barrier()
#define PG8_SCHED __builtin_amdgcn_sched_barrier(0)
    Unit cur, nxt; int ui = 0;
    if (!S.next(0, cur)) return;
    f32x4 acc[2][2][4][2];
#pragma unroll
    for (int a = 0; a < 2; ++a)
#pragma unroll
        for (int b = 0; b < 2; ++b)
#pragma unroll
            for (int m = 0; m < 4; ++m)
#pragma unroll
                for (int n = 0; n < 2; ++n) acc[a][b][m][n] = (f32x4){0.f, 0.f, 0.f, 0.f};
    bf16x8 At[4][2], B0[2][2], B1[2][2];
    const char* cA = (const char*)g.A + (size_t)cur.pm * tstep; const char* cB = (const char*)g.Bt + (size_t)cur.pn * tstep;
    S.a_ready(cur);
    if constexpr (SP2) {
        PG8_STAGE(PG8_SB(0, 0), cB, voffB); PG8_STAGE(PG8_SB(0, 1), cB + hstep, voffB); PG8_STAGE(PG8_SA(0, 0), cA, voffA); PG8_STAGE(PG8_SA(0, 1), cA + hstep, voffA);
        if (wr == 1) PG8_BAR;
        PG8_WAIT_V(2); PG8_BAR;
        PG8_STAGE(PG8_SB(1, 0), cB + kstep, voffB); PG8_STAGE(PG8_SA(1, 0), cA + kstep, voffA); PG8_STAGE(PG8_SB(1, 1), cB + hstep + kstep, voffB);
        PG8_WAIT_V(6); PG8_BAR;
    } else {
        PG8_STAGE(PG8_SB(0, 0), cB, voffB); PG8_STAGE(PG8_SA(0, 0), cA, voffA); PG8_STAGE(PG8_SB(0, 1), cB + hstep, voffB); PG8_STAGE(PG8_SA(0, 1), cA + hstep, voffA);
        if (wr == 1) PG8_BAR;
        PG8_WAIT_V(4); PG8_BAR;
        PG8_STAGE(PG8_SB(1, 0), cB + kstep, voffB); PG8_STAGE(PG8_SA(1, 0), cA + kstep, voffA); PG8_STAGE(PG8_SB(1, 1), cB + hstep + kstep, voffB);
        PG8_WAIT_V(6); PG8_BAR;
    }
    for (;;) {
        const bool has_next = S.next(ui + 1, nxt);
        const char* nA = has_next ? (const char*)g.A + (size_t)nxt.pm * tstep : cA; const char* nB = has_next ? (const char*)g.Bt + (size_t)nxt.pn * tstep : cB;
        for (int t = 0; t < nt; t += 2) {
            const bool last = (t == nt - 2);
            const char* a1 = cA + (size_t)(t + 1) * kstep;
            const char* a2 = last ? nA : cA + (size_t)(t + 2) * kstep; const char* b2 = last ? nB : cB + (size_t)(t + 2) * kstep;
            const char* a3 = a2 + kstep; const char* b3 = b2 + kstep;
            if (last && has_next) S.a_ready(nxt);
            if constexpr (SP2) {
            PG8_LDB(B0, 0, 0); PG8_LDB(B1, 0, 1); PG8_SCHED; PG8_LDA(At, 0, 0); PG8_STAGE(PG8_SA(1, 1), a1 + hstep, voffA);
            PG8_WAIT_V(8); PG8_WAIT_L(0); PG8_BAR; PG8_MMA(0, 0, At, B0); PG8_MMA(0, 1, At, B1); PG8_BAR; PG8_SCHED;
            PG8_LDA(At, 0, 1); PG8_STAGE(PG8_SB(0, 0), b2, voffB); PG8_STAGE(PG8_SB(0, 1), b2 + hstep, voffB); PG8_STAGE(PG8_SA(0, 0), a2, voffA);
            PG8_WAIT_V(8); PG8_WAIT_L(0); PG8_BAR; PG8_MMA(1, 0, At, B0); PG8_MMA(1, 1, At, B1); PG8_BAR; PG8_SCHED;
            PG8_LDB(B0, 1, 0); PG8_LDB(B1, 1, 1); PG8_SCHED; PG8_LDA(At, 1, 0); PG8_STAGE(PG8_SA(0, 1), a2 + hstep, voffA);
            PG8_WAIT_V(8); PG8_WAIT_L(0); PG8_BAR; PG8_MMA(0, 0, At, B0); PG8_MMA(0, 1, At, B1); PG8_BAR; PG8_SCHED;
            PG8_LDA(At, 1, 1); PG8_STAGE(PG8_SB(1, 0), b3, voffB); PG8_STAGE(PG8_SB(1, 1), b3 + hstep, voffB); PG8_STAGE(PG8_SA(1, 0), a3, voffA);
            PG8_WAIT_V(8); PG8_WAIT_L(0); PG8_BAR; PG8_MMA(1, 0, At, B0); PG8_MMA(1, 1, At, B1); PG8_BAR; PG8_SCHED;
            } else {
            PG8_LDB(B0, 0, 0); PG8_SCHED; PG8_LDA(At, 0, 0); PG8_STAGE(PG8_SA(1, 1), a1 + hstep, voffA);
            PG8_WAIT_L(8); PG8_BAR; PG8_WAIT_L(0); PG8_MMA(0, 0, At, B0); PG8_BAR; PG8_SCHED;
            PG8_LDB(B1, 0, 1); PG8_STAGE(PG8_SB(0, 0), b2, voffB);
            PG8_BAR; PG8_WAIT_L(0); PG8_MMA(0, 1, At, B1); PG8_BAR;
            PG8_LDA(At, 0, 1); PG8_STAGE(PG8_SA(0, 0), a2, voffA);
            PG8_BAR; PG8_WAIT_L(0); PG8_MMA(1, 0, At, B0); PG8_BAR; PG8_SCHED;
            PG8_STAGE(PG8_SB(0, 1), b2 + hstep, voffB);
            PG8_WAIT_V(6); PG8_BAR; PG8_MMA(1, 1, At, B1); PG8_BAR;
            PG8_LDB(B0, 1, 0); PG8_SCHED; PG8_LDA(At, 1, 0); PG8_STAGE(PG8_SA(0, 1), a2 + hstep, voffA);
            PG8_WAIT_L(8); PG8_BAR; PG8_WAIT_L(0); PG8_MMA(0, 0, At, B0); PG8_BAR; PG8_SCHED;
            PG8_LDB(B1, 1, 1); PG8_STAGE(PG8_SB(1, 0), b3, voffB);
            PG8_BAR; PG8_WAIT_L(0); PG8_MMA(0, 1, At, B1); PG8_BAR;
            PG8_LDA(At, 1, 1); PG8_STAGE(PG8_SA(1, 0), a3, voffA);
            PG8_BAR; PG8_WAIT_L(0); PG8_MMA(1, 0, At, B0); PG8_BAR; PG8_SCHED;
            PG8_STAGE(PG8_SB(1, 1), b3 + hstep, voffB);
            PG8_WAIT_V(6); PG8_BAR; PG8_MMA(1, 1, At, B1); PG8_BAR;
            }
        }
        if constexpr (ALIGN_EPI) { if (wr == 0) PG8_BAR; }
        if constexpr (!Epi::AFTER_DRAIN) { E(acc, cur, wr, wc, fr, fq); S.done(cur); }
        if (!has_next) break;
#pragma unroll
        for (int a = 0; a < 2; ++a)
#pragma unroll
            for (int b = 0; b < 2; ++b)
#pragma unroll
                for (int m = 0; m < 4; ++m)
#pragma unroll
                    for (int n = 0; n < 2; ++n) acc[a][b][m][n] = (f32x4){0.f, 0.f, 0.f, 0.f};
        cur = nxt; cA = nA; cB = nB; ++ui;
        if constexpr (ALIGN_EPI) { if (wr == 1) PG8_BAR; }
    }
    PG8_WAIT_V(0);
    if constexpr (!ALIGN_EPI) { if (wr == 0) PG8_BAR; }
    PG8_BAR;
    if constexpr (Epi::AFTER_DRAIN) { E.fused(acc, cur, wr, wc, fr, fq, lds, wid, lane); S.done(cur); }
#undef PG8_SA
#undef PG8_SB
#undef PG8_STAGE
#undef PG8_LDA
#undef PG8_LDB
#undef PG8_MMA
#undef PG8_WAIT_V
#undef PG8_WAIT_L
#undef PG8_BAR
#undef PG8_SCHED
}
}
namespace mk {
using pg8::Unit;
__device__ __forceinline__ float ss_to_r(float ss) { return rsqrtf(ss * (1.f / DM) + EPS); }
__device__ __forceinline__ u32x2 pk4(f32x4 v) { return (u32x2){pk2(v[0], v[1]), pk2(v[2], v[3])}; }
__device__ __forceinline__ float sq4(f32x4 v) { return (v[0] * v[0] + v[1] * v[1]) + (v[2] * v[2] + v[3] * v[3]); }
__device__ __forceinline__ float quad_sum(float s) { s += __shfl_xor(s, 16); s += __shfl_xor(s, 32); return s; }
struct FStoreF32 { float* out; int ldc;
    __device__ __forceinline__ void rowquad(int row, int ct, int wc, int fq, f32x4 a00, f32x4 a01, f32x4 a10, f32x4 a11) const {
        float* p = out + (size_t)row * ldc + ct + 32 * wc + 4 * fq; *(f32x4*)p = a00; *(f32x4*)(p + 16) = a01; *(f32x4*)(p + 128) = a10; *(f32x4*)(p + 144) = a11; } };
template <int RES, bool OUTF> struct FResid { float* out; const float* resf; bf16_t* hb; float* ss;
    __device__ __forceinline__ f32x4 ld(size_t o) const { if (RES == 0) return *(const f32x4*)(resf + o); const u32x2 r = *(const u32x2*)(hb + o); return (f32x4){bflo(r.x), bfhi(r.x), bflo(r.y), bfhi(r.y)}; }
    __device__ __forceinline__ void rowquad(int row, int ct, int wc, int fq, f32x4 a00, f32x4 a01, f32x4 a10, f32x4 a11) const {
        const size_t o = (size_t)row * DM + ct + 32 * wc + 4 * fq;
        a00 += ld(o); a01 += ld(o + 16); a10 += ld(o + 128); a11 += ld(o + 144);
        if (OUTF) { *(f32x4*)(out + o) = a00; *(f32x4*)(out + o + 16) = a01; *(f32x4*)(out + o + 128) = a10; *(f32x4*)(out + o + 144) = a11; }
        else { *(u32x2*)(hb + o) = pk4(a00); *(u32x2*)(hb + o + 16) = pk4(a01); *(u32x2*)(hb + o + 128) = pk4(a10); *(u32x2*)(hb + o + 144) = pk4(a11);
            const float st = quad_sum((sq4(a00) + sq4(a01)) + (sq4(a10) + sq4(a11))); if (fq == 0) atomicAdd(ss + row, st); } }
    static constexpr bool WIDE = true;
    __device__ __forceinline__ void ld8(size_t o, f32x4& lo, f32x4& hi) const {
        if (RES == 0) { lo = *(const f32x4*)(resf + o); hi = *(const f32x4*)(resf + o + 4); }
        else { const u32x4 r = *(const u32x4*)(hb + o); lo = (f32x4){bflo(r.x), bfhi(r.x), bflo(r.y), bfhi(r.y)}; hi = (f32x4){bflo(r.z), bfhi(r.z), bflo(r.w), bfhi(r.w)}; } }
    __device__ __forceinline__ void rowquad_w(int row, int ct, int wc, int fq, f32x4 a00, f32x4 a01, f32x4 a10, f32x4 a11) const {
        const size_t o = (size_t)row * DM + ct + 32 * wc + 8 * fq;
        { f32x4 l0, h0, l1, h1; ld8(o, l0, h0); ld8(o + 128, l1, h1); a00 += l0; a01 += h0; a10 += l1; a11 += h1; }
        if (OUTF) { *(f32x4*)(out + o) = a00; *(f32x4*)(out + o + 4) = a01; *(f32x4*)(out + o + 128) = a10; *(f32x4*)(out + o + 132) = a11; }
        else { const u32x2 p0 = pk4(a00), p1 = pk4(a01), p2 = pk4(a10), p3 = pk4(a11);
            *(u32x4*)(hb + o) = (u32x4){p0.x, p0.y, p1.x, p1.y}; *(u32x4*)(hb + o + 128) = (u32x4){p2.x, p2.y, p3.x, p3.y};
            const float st = quad_sum((sq4(a00) + sq4(a01)) + (sq4(a10) + sq4(a11))); if (fq == 0) atomicAdd(ss + row, st); } } };
__device__ __forceinline__ float silu_f(float g) { return g * __builtin_amdgcn_rcpf(1.0f + __expf(-g)); }
struct FSwiglu { bf16_t* out; const float* ss;
    __device__ __forceinline__ void rowquad(int row, int ct, int wc, int fq, f32x4 a00, f32x4 a01, f32x4 a10, f32x4 a11) const {
#ifdef EXP_NOEPI
        { const f32x4 sm = (a00 + a01) + (a10 + a11); if (sm[0] + sm[1] + sm[2] + sm[3] == 12345.678f) out[row] = 1; return; }
#endif
#ifdef EXP_NOSS
        const float rs = 1.f;
#else
        const float rs = ss_to_r(ss[row]);
#endif
        a00 *= rs; a01 *= rs; a10 *= rs; a11 *= rs;
        bf16_t* p = out + (size_t)row * DFF + (ct >> 1) + 32 * wc + 4 * fq;
        *(u32x2*)p = (u32x2){pk2(silu_f(a00[0]) * a10[0], silu_f(a00[1]) * a10[1]), pk2(silu_f(a00[2]) * a10[2], silu_f(a00[3]) * a10[3])};
        *(u32x2*)(p + 16) = (u32x2){pk2(silu_f(a01[0]) * a11[0], silu_f(a01[1]) * a11[1]), pk2(silu_f(a01[2]) * a11[2], silu_f(a01[3]) * a11[3])}; }
    static constexpr bool WIDE = true;
    __device__ __forceinline__ void rowquad_w(int row, int ct, int wc, int fq, f32x4 a00, f32x4 a01, f32x4 a10, f32x4 a11) const {
        const float rs = ss_to_r(ss[row]); a00 *= rs; a01 *= rs; a10 *= rs; a11 *= rs;
        bf16_t* p = out + (size_t)row * DFF + (ct >> 1) + 32 * wc + 8 * fq;
        *(u32x4*)p = (u32x4){pk2(silu_f(a00[0]) * a10[0], silu_f(a00[1]) * a10[1]), pk2(silu_f(a00[2]) * a10[2], silu_f(a00[3]) * a10[3]),
                             pk2(silu_f(a01[0]) * a11[0], silu_f(a01[1]) * a11[1]), pk2(silu_f(a01[2]) * a11[2], silu_f(a01[3]) * a11[3])}; } };
__device__ __forceinline__ void head_store4(bf16_t* p, const float* g, float rn, f32x4 a00, f32x4 a01, f32x4 a10, f32x4 a11) {
    *(u32x2*)p = pk4(a00 * rn * *(const f32x4*)g); asm volatile("" ::: "memory");
    *(u32x2*)(p + 16) = pk4(a01 * rn * *(const f32x4*)(g + 16)); asm volatile("" ::: "memory");
    *(u32x2*)(p + 32) = pk4(a10 * rn * *(const f32x4*)(g + 32)); asm volatile("" ::: "memory");
    *(u32x2*)(p + 48) = pk4(a11 * rn * *(const f32x4*)(g + 48)); }
__device__ __forceinline__ void head_store4_w(bf16_t* p, const float* g, float rn, int fq, f32x4 a00, f32x4 a01, f32x4 a10, f32x4 a11) {
    const u32x2 q0 = pk4(a00 * rn * *(const f32x4*)(g + 8 * fq)), q1 = pk4(a01 * rn * *(const f32x4*)(g + 8 * fq + 4));
    *(u32x4*)(p + 8 * fq) = (u32x4){q0.x, q0.y, q1.x, q1.y}; asm volatile("" ::: "memory");
    const u32x2 q2 = pk4(a10 * rn * *(const f32x4*)(g + 32 + 8 * fq)), q3 = pk4(a11 * rn * *(const f32x4*)(g + 36 + 8 * fq));
    *(u32x4*)(p + 32 + 8 * fq) = (u32x4){q2.x, q2.y, q3.x, q3.y}; }
struct FPostA { bf16_t* cq; bf16_t* ckv; bf16_t* kpe; float* ssq; float* sskv; float* rows; const float* g_qc; const float* g_ckv; const float* g_kr; const float* cosA; const float* sinA;
    __device__ __forceinline__ void rowquad(int row, int ct, int wc, int fq, f32x4 a00, f32x4 a01, f32x4 a10, f32x4 a11) const {
        const int pn = ct >> 8, cb = 32 * wc + 4 * fq;
        if (pn == 0) { const float st = quad_sum((sq4(a00) + sq4(a01)) + (sq4(a10) + sq4(a11))); if (fq == 0) atomicAdd(ssq + row, st);
            bf16_t* p = cq + (size_t)row * DQC + cb; const float* g = g_qc + cb;
            *(u32x2*)p = pk4(a00 * *(const f32x4*)g); *(u32x2*)(p + 16) = pk4(a01 * *(const f32x4*)(g + 16)); *(u32x2*)(p + 128) = pk4(a10 * *(const f32x4*)(g + 128)); *(u32x2*)(p + 144) = pk4(a11 * *(const f32x4*)(g + 144)); }
        else if (pn == 2) { const float st = quad_sum((sq4(a00) + sq4(a01)) + (sq4(a10) + sq4(a11))); if (fq == 0) atomicAdd(sskv + row, st);
            bf16_t* p = ckv + (size_t)row * DC + cb; const float* g = g_ckv + cb;
            *(u32x2*)p = pk4(a00 * *(const f32x4*)g); *(u32x2*)(p + 16) = pk4(a01 * *(const f32x4*)(g + 16)); *(u32x2*)(p + 128) = pk4(a10 * *(const f32x4*)(g + 128)); *(u32x2*)(p + 144) = pk4(a11 * *(const f32x4*)(g + 144)); }
        else { const float st = quad_sum(sq4(a00) + sq4(a01)); if (fq == 0) atomicAdd(ssq + row, st);
            bf16_t* p = cq + (size_t)row * DQC + 256 + cb; const float* g = g_qc + 256 + cb;
            *(u32x2*)p = pk4(a00 * *(const f32x4*)g); *(u32x2*)(p + 16) = pk4(a01 * *(const f32x4*)(g + 16));
            if (wc == 0) { const float r = rsqrtf(quad_sum(sq4(a10) + sq4(a11)) * (1.f / 32) + EPS); const int pi = tok_pidx(row);
                const f32x4 v1 = a10 * r * *(const f32x4*)(g_kr + 4 * fq), v2 = a11 * r * *(const f32x4*)(g_kr + 16 + 4 * fq);
                const f32x4 c = *(const f32x4*)(cosA + pi * 16 + 4 * fq), s = *(const f32x4*)(sinA + pi * 16 + 4 * fq);
                const f32x4 o1 = v1 * c - v2 * s, o2 = v2 * c + v1 * s;
                *(u32x2*)(kpe + (size_t)row * 32 + 4 * fq) = pk4(o1); *(u32x2*)(kpe + (size_t)row * 32 + 16 + 4 * fq) = pk4(o2);
                *(f32x4*)(rows + (size_t)row * DCKV + DC + 4 * fq) = o1; *(f32x4*)(rows + (size_t)row * DCKV + DC + 16 + 4 * fq) = o2; } } }
    static constexpr bool WIDE = true;
    static __device__ __forceinline__ u32x4 pk8(f32x4 lo, f32x4 hi) { const u32x2 a = pk4(lo), b = pk4(hi); return (u32x4){a.x, a.y, b.x, b.y}; }
    __device__ __forceinline__ void rowquad_w(int row, int ct, int wc, int fq, f32x4 a00, f32x4 a01, f32x4 a10, f32x4 a11) const {
        const int pn = ct >> 8, cb = 32 * wc + 8 * fq;
        if (pn == 0) { const float st = quad_sum((sq4(a00) + sq4(a01)) + (sq4(a10) + sq4(a11))); if (fq == 0) atomicAdd(ssq + row, st);
            bf16_t* p = cq + (size_t)row * DQC + cb; const float* g = g_qc + cb;
            *(u32x4*)p = pk8(a00 * *(const f32x4*)g, a01 * *(const f32x4*)(g + 4)); *(u32x4*)(p + 128) = pk8(a10 * *(const f32x4*)(g + 128), a11 * *(const f32x4*)(g + 132)); }
        else if (pn == 2) { const float st = quad_sum((sq4(a00) + sq4(a01)) + (sq4(a10) + sq4(a11))); if (fq == 0) atomicAdd(sskv + row, st);
            bf16_t* p = ckv + (size_t)row * DC + cb; const float* g = g_ckv + cb;
            *(u32x4*)p = pk8(a00 * *(const f32x4*)g, a01 * *(const f32x4*)(g + 4)); *(u32x4*)(p + 128) = pk8(a10 * *(const f32x4*)(g + 128), a11 * *(const f32x4*)(g + 132)); }
        else { const float st = quad_sum(sq4(a00) + sq4(a01)); if (fq == 0) atomicAdd(ssq + row, st);
            bf16_t* p = cq + (size_t)row * DQC + 256 + cb; const float* g = g_qc + 256 + cb;
            *(u32x4*)p = pk8(a00 * *(const f32x4*)g, a01 * *(const f32x4*)(g + 4));
            if (wc == 0) { const float r = rsqrtf(quad_sum(sq4(a10) + sq4(a11)) * (1.f / 32) + EPS); const int pi = tok_pidx(row);
                const f32x4 va = a10 * r * *(const f32x4*)(g_kr + 8 * fq), vb = a11 * r * *(const f32x4*)(g_kr + 8 * fq + 4);
                f32x4 oa, ob;
#pragma unroll
                for (int e = 0; e < 4; ++e) { oa[e] = __shfl_xor(va[e], 32); ob[e] = __shfl_xor(vb[e], 32); }
                const int ci = pi * 16 + 8 * (fq & 1); const float sg = fq < 2 ? -1.f : 1.f;
                const f32x4 ca = *(const f32x4*)(cosA + ci), cb2 = *(const f32x4*)(cosA + ci + 4), sa = *(const f32x4*)(sinA + ci) * sg, sb = *(const f32x4*)(sinA + ci + 4) * sg;
                const f32x4 ra = va * ca + oa * sa, rb = vb * cb2 + ob * sb;
                *(u32x4*)(kpe + (size_t)row * 32 + 8 * fq) = pk8(ra, rb);
                *(f32x4*)(rows + (size_t)row * DCKV + DC + 8 * fq) = ra; *(f32x4*)(rows + (size_t)row * DCKV + DC + 8 * fq + 4) = rb; } } } };
struct FMlaQN { bf16_t* qf; const float* g_qn; const float* ssq;
    __device__ __forceinline__ void rowquad(int row, int ct, int wc, int fq, f32x4 a00, f32x4 a01, f32x4 a10, f32x4 a11) const {
        { const float rq = rsqrtf(ssq[row] * (1.f / DQC) + EPS); a00 *= rq; a01 *= rq; a10 *= rq; a11 *= rq; }
        const int head = (ct >> 6) + wc; const float rn = rsqrtf(quad_sum((sq4(a00) + sq4(a01)) + (sq4(a10) + sq4(a11))) * (1.f / 64) + EPS) * (SCALE_A * LOG2E);
        head_store4(qf + ((size_t)row * 16 + head) * 96 + 4 * fq, g_qn + 4 * fq, rn, a00, a01, a10, a11); }
    static constexpr bool WIDE = true;
    __device__ __forceinline__ void rowquad_w(int row, int ct, int wc, int fq, f32x4 a00, f32x4 a01, f32x4 a10, f32x4 a11) const {
        { const float rq = rsqrtf(ssq[row] * (1.f / DQC) + EPS); a00 *= rq; a01 *= rq; a10 *= rq; a11 *= rq; }
        const int head = (ct >> 6) + wc; const float rn = rsqrtf(quad_sum((sq4(a00) + sq4(a01)) + (sq4(a10) + sq4(a11))) * (1.f / 64) + EPS) * (SCALE_A * LOG2E);
        bf16_t* p = qf + ((size_t)row * 16 + head) * 96 + 8 * fq; const float* g = g_qn + 8 * fq;
        a00 = a00 * rn * *(const f32x4*)g; a01 = a01 * rn * *(const f32x4*)(g + 4);
        { const u32x2 q0 = pk4(a00), q1 = pk4(a01); *(u32x4*)p = (u32x4){q0.x, q0.y, q1.x, q1.y}; } asm volatile("" ::: "memory");
        a10 = a10 * rn * *(const f32x4*)(g + 32); a11 = a11 * rn * *(const f32x4*)(g + 36);
        { const u32x2 q2 = pk4(a10), q3 = pk4(a11); *(u32x4*)(p + 32) = (u32x4){q2.x, q2.y, q3.x, q3.y}; } } };
struct FMlaQR { bf16_t* qf; const float* g_qr; const float* cosA; const float* sinA; const float* ssq;
    __device__ __forceinline__ void half(int row, int head, int fq, f32x4 x1, f32x4 x2) const {
        { const float rq = rsqrtf(ssq[row] * (1.f / DQC) + EPS); x1 *= rq; x2 *= rq; }
        const float r = rsqrtf(quad_sum(sq4(x1) + sq4(x2)) * (1.f / 32) + EPS) * (SCALE_A * LOG2E);
        const int pi = tok_pidx(row);
        x1 = x1 * r * *(const f32x4*)(g_qr + 4 * fq); x2 = x2 * r * *(const f32x4*)(g_qr + 16 + 4 * fq);
        const f32x4 c = *(const f32x4*)(cosA + pi * 16 + 4 * fq), s = *(const f32x4*)(sinA + pi * 16 + 4 * fq);
        bf16_t* p = qf + ((size_t)row * 16 + head) * 96 + 64 + 4 * fq; *(u32x2*)p = pk4(x1 * c - x2 * s); *(u32x2*)(p + 16) = pk4(x2 * c + x1 * s);
        asm volatile("" ::: "memory"); }
    __device__ __forceinline__ void rowquad(int row, int ct, int wc, int fq, f32x4 a00, f32x4 a01, f32x4 a10, f32x4 a11) const {
        const int h0 = 8 * (ct >> 8) + wc; half(row, h0, fq, a00, a01); half(row, h0 + 4, fq, a10, a11); }
    static constexpr bool WIDE = true;
    __device__ __forceinline__ void half_w(int row, int head, int fq, f32x4 xa, f32x4 xb) const {
        { const float rq = rsqrtf(ssq[row] * (1.f / DQC) + EPS); xa *= rq; xb *= rq; }
        const float r = rsqrtf(quad_sum(sq4(xa) + sq4(xb)) * (1.f / 32) + EPS) * (SCALE_A * LOG2E);
        const int pi = tok_pidx(row);
        xa = xa * r * *(const f32x4*)(g_qr + 8 * fq); xb = xb * r * *(const f32x4*)(g_qr + 8 * fq + 4);
        f32x4 oa, ob;
#pragma unroll
        for (int e = 0; e < 4; ++e) { oa[e] = __shfl_xor(xa[e], 32); ob[e] = __shfl_xor(xb[e], 32); }
        const int ci = pi * 16 + 8 * (fq & 1); const float sg = fq < 2 ? -1.f : 1.f;
        const f32x4 ca = *(const f32x4*)(cosA + ci), cb = *(const f32x4*)(cosA + ci + 4), sa = *(const f32x4*)(sinA + ci) * sg, sb = *(const f32x4*)(sinA + ci + 4) * sg;
        const u32x2 q0 = pk4(xa * ca + oa * sa), q1 = pk4(xb * cb + ob * sb);
        *(u32x4*)(qf + ((size_t)row * 16 + head) * 96 + 64 + 8 * fq) = (u32x4){q0.x, q0.y, q1.x, q1.y};
        asm volatile("" ::: "memory"); }
    __device__ __forceinline__ void rowquad_w(int row, int ct, int wc, int fq, f32x4 a00, f32x4 a01, f32x4 a10, f32x4 a11) const {
        const int h0 = 8 * (ct >> 8) + wc; half_w(row, h0, fq, a00, a01); half_w(row, h0 + 4, fq, a10, a11); } };
struct FKnV { bf16_t* kn; bf16_t* knv; const float* g_kn; const float* sskv;
    __device__ __forceinline__ void rowquad(int row, int ct, int wc, int fq, f32x4 a00, f32x4 a01, f32x4 a10, f32x4 a11) const {
        { const float rk = rsqrtf(sskv[row] * (1.f / DC) + EPS); a00 *= rk; a01 *= rk; a10 *= rk; a11 *= rk; }
        if (ct < 1024) { const int head = (ct >> 6) + wc; const float rn = rsqrtf(quad_sum((sq4(a00) + sq4(a01)) + (sq4(a10) + sq4(a11))) * (1.f / 64) + EPS);
            head_store4(kn + (size_t)row * 1024 + head * 64 + 4 * fq, g_kn + 4 * fq, rn, a00, a01, a10, a11); }
        else { bf16_t* p = knv + (size_t)row * 2048 + ct + 32 * wc + 4 * fq; *(u32x2*)p = pk4(a00); *(u32x2*)(p + 16) = pk4(a01); *(u32x2*)(p + 128) = pk4(a10); *(u32x2*)(p + 144) = pk4(a11); } }
    static constexpr bool WIDE = true;
    __device__ __forceinline__ void rowquad_w(int row, int ct, int wc, int fq, f32x4 a00, f32x4 a01, f32x4 a10, f32x4 a11) const {
        { const float rk = rsqrtf(sskv[row] * (1.f / DC) + EPS); a00 *= rk; a01 *= rk; a10 *= rk; a11 *= rk; }
        if (ct < 1024) { const int head = (ct >> 6) + wc; const float rn = rsqrtf(quad_sum((sq4(a00) + sq4(a01)) + (sq4(a10) + sq4(a11))) * (1.f / 64) + EPS);
            head_store4_w(kn + (size_t)row * 1024 + head * 64, g_kn, rn, fq, a00, a01, a10, a11); }
        else { bf16_t* p = knv + (size_t)row * 2048 + ct + 32 * wc + 8 * fq; const u32x2 p0 = pk4(a00), p1 = pk4(a01), p2 = pk4(a10), p3 = pk4(a11);
            *(u32x4*)p = (u32x4){p0.x, p0.y, p1.x, p1.y}; *(u32x4*)(p + 128) = (u32x4){p2.x, p2.y, p3.x, p3.y}; } } };
struct FKvq { bf16_t* ks; bf16_t* vs; bf16_t* qbf; const float* ss; const float* g_k; const float* g_q; const float* cosB; const float* sinB; float* out;
    __device__ __forceinline__ void winptr(int row, float*& wk, float*& wv) const {
        float* out_wkp = out + (size_t)T * DM + (size_t)T * DCKV; float* out_wvp = out_wkp + (size_t)NB * WIN * 256; float* out_wks = out_wvp + (size_t)NB * WIN * 256; float* out_wvs = out_wks + (size_t)DB * WIN * 256;
        wk = nullptr; wv = nullptr;
        if (row < TP) { const int b = row / SEQ, s = row % SEQ; if (s >= SEQ - WIN) { wk = out_wkp + ((size_t)b * WIN + (s - (SEQ - WIN))) * 256; wv = out_wvp + ((size_t)b * WIN + (s - (SEQ - WIN))) * 256; } }
        else { const int b = (row - TP) / DS, tt = (row - TP) % DS; wk = out_wks + ((size_t)b * WIN + (WIN - DS) + tt) * 256; wv = out_wvs + ((size_t)b * WIN + (WIN - DS) + tt) * 256; } }
    __device__ __forceinline__ void rowquad(int row, int ct, int wc, int fq, f32x4 a00, f32x4 a01, f32x4 a10, f32x4 a11) const {
        const float rs = ss_to_r(ss[row]); a00 *= rs; a01 *= rs; a10 *= rs; a11 *= rs;
        const int pn = ct >> 8;
        if (pn == 1) { float* wk; float* wv; winptr(row, wk, wv); const int cb = 32 * wc + 4 * fq;
            bf16_t* p = vs + (size_t)row * 256 + cb; *(u32x2*)p = pk4(a00); *(u32x2*)(p + 16) = pk4(a01); *(u32x2*)(p + 128) = pk4(a10); *(u32x2*)(p + 144) = pk4(a11);
            if (wv) { *(f32x4*)(wv + cb) = a00; *(f32x4*)(wv + cb + 16) = a01; *(f32x4*)(wv + cb + 128) = a10; *(f32x4*)(wv + cb + 144) = a11; }
            return; }
        const bool isk = pn == 0; const float* g = (isk ? g_k : g_q) + 4 * fq;
        const float rn = rsqrtf(quad_sum((sq4(a00) + sq4(a01)) + (sq4(a10) + sq4(a11))) * (1.f / 64) + EPS) * (isk ? 1.f : SCALE_B * LOG2E);
        a00 = a00 * rn * *(const f32x4*)g; a01 = a01 * rn * *(const f32x4*)(g + 16); a10 = a10 * rn * *(const f32x4*)(g + 32); a11 = a11 * rn * *(const f32x4*)(g + 48);
        { const int pi = tok_pidx(row); const f32x4 c = *(const f32x4*)(cosB + pi * 8 + 4 * (fq & 1)), s = *(const f32x4*)(sinB + pi * 8 + 4 * (fq & 1));
          f32x4 other; other[0] = __shfl_xor(a00[0], 32); other[1] = __shfl_xor(a00[1], 32); other[2] = __shfl_xor(a00[2], 32); other[3] = __shfl_xor(a00[3], 32);
          a00 = (fq < 2) ? (a00 * c - other * s) : (a00 * c + other * s); }
        if (isk) { float* wk; float* wv; winptr(row, wk, wv); const int cb = 64 * wc + 4 * fq;
            bf16_t* p = ks + (size_t)row * 256 + cb; *(u32x2*)p = pk4(a00); *(u32x2*)(p + 16) = pk4(a01); *(u32x2*)(p + 32) = pk4(a10); *(u32x2*)(p + 48) = pk4(a11);
            if (wk) { *(f32x4*)(wk + cb) = a00; *(f32x4*)(wk + cb + 16) = a01; *(f32x4*)(wk + cb + 32) = a10; *(f32x4*)(wk + cb + 48) = a11; } }
        else { bf16_t* p = qbf + (size_t)row * 1024 + (4 * (pn - 2) + wc) * 64 + 4 * fq; *(u32x2*)p = pk4(a00); *(u32x2*)(p + 16) = pk4(a01); *(u32x2*)(p + 32) = pk4(a10); *(u32x2*)(p + 48) = pk4(a11); } }
    static constexpr bool WIDE = true;
    static __device__ __forceinline__ u32x4 pk8(f32x4 lo, f32x4 hi) { const u32x2 a = pk4(lo), b = pk4(hi); return (u32x4){a.x, a.y, b.x, b.y}; }
    __device__ __forceinline__ void rowquad_w(int row, int ct, int wc, int fq, f32x4 a00, f32x4 a01, f32x4 a10, f32x4 a11) const {
        const float rs = ss_to_r(ss[row]); a00 *= rs; a01 *= rs; a10 *= rs; a11 *= rs;
        const int pn = ct >> 8;
        if (pn == 1) { float* wk; float* wv; winptr(row, wk, wv); const int cb = 32 * wc + 8 * fq;
            bf16_t* p = vs + (size_t)row * 256 + cb; *(u32x4*)p = pk8(a00, a01); *(u32x4*)(p + 128) = pk8(a10, a11);
            if (wv) { *(f32x4*)(wv + cb) = a00; *(f32x4*)(wv + cb + 4) = a01; *(f32x4*)(wv + cb + 128) = a10; *(f32x4*)(wv + cb + 132) = a11; }
            return; }
        const bool isk = pn == 0; const float* g = (isk ? g_k : g_q) + 8 * fq;
        const float rn = rsqrtf(quad_sum((sq4(a00) + sq4(a01)) + (sq4(a10) + sq4(a11))) * (1.f / 64) + EPS) * (isk ? 1.f : SCALE_B * LOG2E);
        a00 = a00 * rn * *(const f32x4*)g; a01 = a01 * rn * *(const f32x4*)(g + 4); a10 = a10 * rn * *(const f32x4*)(g + 32); a11 = a11 * rn * *(const f32x4*)(g + 36);
        { f32x4 o0, o1;
#pragma unroll
          for (int e = 0; e < 4; ++e) { o0[e] = __shfl_xor(a00[e], 16); o1[e] = __shfl_xor(a01[e], 16); }
          if (fq < 2) { const int pi = tok_pidx(row); const float sg = fq == 0 ? -1.f : 1.f;
            const f32x4 c0 = *(const f32x4*)(cosB + pi * 8), c1 = *(const f32x4*)(cosB + pi * 8 + 4), s0 = *(const f32x4*)(sinB + pi * 8) * sg, s1 = *(const f32x4*)(sinB + pi * 8 + 4) * sg;
            a00 = a00 * c0 + o0 * s0; a01 = a01 * c1 + o1 * s1; } }
        if (isk) { float* wk; float* wv; winptr(row, wk, wv); const int cb = 64 * wc + 8 * fq;
            bf16_t* p = ks + (size_t)row * 256 + cb; *(u32x4*)p = pk8(a00, a01); *(u32x4*)(p + 32) = pk8(a10, a11);
            if (wk) { *(f32x4*)(wk + cb) = a00; *(f32x4*)(wk + cb + 4) = a01; *(f32x4*)(wk + cb + 32) = a10; *(f32x4*)(wk + cb + 36) = a11; } }
        else { bf16_t* p = qbf + (size_t)row * 1024 + (4 * (pn - 2) + wc) * 64 + 8 * fq; *(u32x4*)p = pk8(a00, a01); *(u32x4*)(p + 32) = pk8(a10, a11); } } };

template <class T, class = void> struct epi_wide { static constexpr bool value = false; };
template <class T> struct epi_wide<T, decltype((void)T::WIDE)> { static constexpr bool value = T::WIDE; };
template <class F> struct EpiAdapt {
    static constexpr bool PERM = epi_wide<F>::value, AFTER_DRAIN = false; F f;
    __device__ __forceinline__ void operator()(const f32x4 (&acc)[2][2][4][2], const Unit& u, int wr, int wc, int fr, int fq) const {
        { const int l_ = lane_id_fresh(); fr = l_ & 15; fq = l_ >> 4; }
#pragma unroll
        for (int ai = 0; ai < 2; ++ai)
#pragma unroll
            for (int m = 0; m < 4; ++m) {
                if constexpr (PERM) f.rowquad_w(u.pm * 256 + ai * 128 + wr * 64 + m * 16 + fr, u.pn * 256, wc, fq, acc[ai][0][m][0], acc[ai][0][m][1], acc[ai][1][m][0], acc[ai][1][m][1]);
                else f.rowquad(u.pm * 256 + ai * 128 + wr * 64 + m * 16 + fr, u.pn * 256, wc, fq, acc[ai][0][m][0], acc[ai][0][m][1], acc[ai][1][m][0], acc[ai][1][m][1]);
                if (m == 3) asm volatile("" ::: "memory"); }
    }
    __device__ __forceinline__ void fused(f32x4 (&)[2][2][4][2], const Unit&, int, int, int, int, PG8_LAS unsigned char*, int, int) const {}
};

template <class F, bool AL = true, bool SP = true> __device__ __forceinline__ void big_gemm(LAS unsigned char* lds, const bf16_t* A, const bf16_t* Bt, int M, int N, int K, const F& f, int wave_id) {
    pg8::Gemm g{A, Bt, M, N, K}; pg8::StaticOrder S; S.init(M, N, (int)gridDim.x, (int)blockIdx.x);
    EpiAdapt<F> E{f};
    pg8::gemm_phase<EpiAdapt<F>, pg8::StaticOrder, AL, SP>(lds, g, S, E, wave_id);
}
template <class F> __device__ __forceinline__ void skinny_gemm(LAS unsigned char* lds, const bf16_t* A, const bf16_t* Bt, int N, int K, const F& f, int wave, int lane_unused, int blk0 = 0) {
    const int lane = lane_id_fresh(); (void)lane_unused;
    const int fr = lane & 15, fq = lane >> 4, ntask = N / 8, nks = K / 32;
    LAS f32x4* red = (LAS f32x4*)lds;
    if ((int)blockIdx.x < blk0) return;
    for (int task = blockIdx.x - blk0; task < ntask; task += gridDim.x - blk0) {
        const int rg = task & 7, wc = (task >> 3) & 3, pn = task >> 5;
        const bf16_t* ap = A + (size_t)(TP + 16 * rg + fr) * K + 8 * fq;
        const bf16_t* bp = Bt + (size_t)(256 * pn + 32 * wc + fr) * K + 8 * fq;
        f32x4 acc[2][2];
#pragma unroll
        for (int bj = 0; bj < 2; ++bj)
#pragma unroll
            for (int n = 0; n < 2; ++n) acc[bj][n] = (f32x4){0.f, 0.f, 0.f, 0.f};
#pragma unroll 1
        for (int ks0 = wave; ks0 < nks; ks0 += 32) {
            bf16x8 av[4], bv[4][4];
#pragma unroll
            for (int u = 0; u < 4; ++u) { const int ks = ks0 + 8 * u; const bool on = ks < nks; const int kk = on ? ks : ks0;
                av[u] = *(const bf16x8*)(ap + 32 * kk); if (!on) av[u] = (bf16x8){0, 0, 0, 0, 0, 0, 0, 0};
#pragma unroll
                for (int q = 0; q < 4; ++q) bv[u][q] = *(const bf16x8*)(bp + (size_t)(128 * (q >> 1) + 16 * (q & 1)) * K + 32 * kk); }
#pragma unroll
            for (int u = 0; u < 4; ++u)
#pragma unroll
                for (int bj = 0; bj < 2; ++bj)
#pragma unroll
                    for (int n = 0; n < 2; ++n) acc[bj][n] = __builtin_amdgcn_mfma_f32_16x16x32_bf16(bv[u][bj * 2 + n], av[u], acc[bj][n], 0, 0, 0);
        }
#pragma unroll
        for (int bj = 0; bj < 2; ++bj)
#pragma unroll
            for (int n = 0; n < 2; ++n) red[(wave * 4 + bj * 2 + n) * 64 + lane] = acc[bj][n];
        __syncthreads();
        if (wave == 0) {
            f32x4 v[4];
#pragma unroll
            for (int q = 0; q < 4; ++q) { v[q] = (f32x4){0.f, 0.f, 0.f, 0.f};
#pragma unroll
                for (int ww = 0; ww < 8; ++ww) v[q] += red[(ww * 4 + q) * 64 + lane]; }
            f.rowquad(TP + 16 * rg + fr, 256 * pn, wc, fq, v[0], v[1], v[2], v[3]);
        }
        __syncthreads();
    }
}

template <class F> __device__ __forceinline__ void wave_gemm64(const bf16_t* A, int M, const bf16_t* Bt, int N, int K, const F& f, int gw, int ngw, int lane_unused) {
    const int lane = lane_id_fresh(); (void)lane_unused;
    const int fr = lane & 15, fq = lane >> 4, ncol = N / 64, ntask = (M / 64) * ncol;
    for (int task = gw; task < ntask; task += ngw) {
        const int cg = task % ncol, rg = task / ncol, pn = cg >> 2, wc = cg & 3;
        const bf16_t* ap = A + (size_t)(64 * rg + fr) * K + 8 * fq;
        const bf16_t* bp = Bt + (size_t)(256 * pn + 32 * wc + fr) * K + 8 * fq;
        f32x4 acc[4][2][2];
#pragma unroll
        for (int rs = 0; rs < 4; ++rs)
#pragma unroll
            for (int bj = 0; bj < 2; ++bj)
#pragma unroll
                for (int n = 0; n < 2; ++n) acc[rs][bj][n] = (f32x4){0.f, 0.f, 0.f, 0.f};
#pragma unroll 2
        for (int ks = 0; ks < K / 32; ++ks) {
            bf16x8 a[4], b[2][2];
#pragma unroll
            for (int rs = 0; rs < 4; ++rs) a[rs] = *(const bf16x8*)(ap + (size_t)(16 * rs) * K + 32 * ks);
#pragma unroll
            for (int bj = 0; bj < 2; ++bj)
#pragma unroll
                for (int n = 0; n < 2; ++n) b[bj][n] = *(const bf16x8*)(bp + (size_t)(128 * bj + 16 * n) * K + 32 * ks);
#pragma unroll
            for (int rs = 0; rs < 4; ++rs)
#pragma unroll
                for (int bj = 0; bj < 2; ++bj)
#pragma unroll
                    for (int n = 0; n < 2; ++n) acc[rs][bj][n] = __builtin_amdgcn_mfma_f32_16x16x32_bf16(b[bj][n], a[rs], acc[rs][bj][n], 0, 0, 0);
        }
#pragma unroll
        for (int rs = 0; rs < 4; ++rs) f.rowquad(64 * rg + 16 * rs + fr, 256 * pn, wc, fq, acc[rs][0][0], acc[rs][0][1], acc[rs][1][0], acc[rs][1][1]);
    }
}

constexpr size_t MiB = 1u << 20;
constexpr size_t WS_CTL = 0, CTL_ZERO_BYTES = 256 * 1024;
constexpr size_t WS_BND = 512 * 1024;
constexpr size_t WS_ROPE = 1 * MiB;
constexpr size_t WS_WAIN = 2 * MiB, WS_WUQ = 4 * MiB, WS_WUK = 6 * MiB, WS_WUV = 6 * MiB + 512 * 1024, WS_WAOUT = 8 * MiB;
constexpr size_t WS_WFIN0 = 10 * MiB, WS_WFIN1 = 21 * MiB, WS_WFOUT0 = 32 * MiB, WS_WFOUT1 = 38 * MiB, WS_WKVQ = 44 * MiB, WS_WBOUT = 47 * MiB;
constexpr size_t WS_HB = 50 * MiB;
constexpr size_t WS_AF = 84 * MiB;
constexpr size_t WS_CQ = 136 * MiB;
constexpr size_t WS_CKV = 150 * MiB;
constexpr size_t WS_KPE = 160 * MiB;
constexpr size_t WS_QRAW = 162 * MiB;
constexpr size_t WS_KNRAW = 214 * MiB;
constexpr size_t WS_VT = 248 * MiB;
constexpr size_t WS_QF = 282 * MiB;
constexpr size_t WS_KN = 334 * MiB;
constexpr size_t WS_O = 368 * MiB;
constexpr size_t WS_PART = 402 * MiB;
constexpr size_t WS_PARTL = 418 * MiB;
constexpr size_t WS_H1 = 420 * MiB;
constexpr size_t WS_H2 = 486 * MiB;
constexpr size_t WS_ACT = 552 * MiB;
constexpr size_t WS_KVF = 642 * MiB;
constexpr size_t WS_QBRAW = 676 * MiB;
constexpr size_t WS_VST = 710 * MiB;
constexpr size_t WS_KS = 720 * MiB;
constexpr size_t WS_VS = 730 * MiB;
constexpr size_t WS_QBF = 740 * MiB;
constexpr size_t WS_SS = 776 * MiB;
constexpr size_t WS_END = 778 * MiB;
constexpr int CW_BAR = 4096;

constexpr int RING_BYTES = 131072, MISC_OFF = 163584, LDS_BYTES = 163840;

struct Args { const void* in[28]; float* out; unsigned char* ws; int ph_lo, ph_hi, li, never, flags, pad; };

struct Ctx {
    LAS unsigned char* lds; int tid, lane, wave, gw, ngw; unsigned char* ws; float* out;
    const Args& a;
    __device__ __forceinline__ const float* x_prompt() const { return (const float*)a.in[0]; }
    __device__ __forceinline__ const float* x_sample() const { return (const float*)a.in[1]; }
    __device__ __forceinline__ const float* cache() const { return (const float*)a.in[2]; }
    __device__ __forceinline__ const float* swk() const { return (const float*)a.in[3]; }
    __device__ __forceinline__ const float* swv() const { return (const float*)a.in[4]; }
    __device__ __forceinline__ const int* page_table() const { return (const int*)a.in[5]; }
    __device__ __forceinline__ const float* norm_attn() const { return (const float*)a.in[6]; }
    __device__ __forceinline__ const float* norm_ffn() const { return (const float*)a.in[7]; }
    __device__ __forceinline__ const float* w_a_in() const { return (const float*)a.in[8]; }
    __device__ __forceinline__ const float* g_qc() const { return (const float*)a.in[9]; }
    __device__ __forceinline__ const float* w_uq() const { return (const float*)a.in[10]; }
    __device__ __forceinline__ const float* g_ckv() const { return (const float*)a.in[11]; }
    __device__ __forceinline__ const float* w_uk() const { return (const float*)a.in[12]; }
    __device__ __forceinline__ const float* w_uv() const { return (const float*)a.in[13]; }
    __device__ __forceinline__ const float* g_qn() const { return (const float*)a.in[14]; }
    __device__ __forceinline__ const float* g_qr() const { return (const float*)a.in[15]; }
    __device__ __forceinline__ const float* g_kn() const { return (const float*)a.in[16]; }
    __device__ __forceinline__ const float* g_kr() const { return (const float*)a.in[17]; }
    __device__ __forceinline__ const float* w_a_out() const { return (const float*)a.in[18]; }
    __device__ __forceinline__ const float* g_kv() const { return (const float*)a.in[19]; }
    __device__ __forceinline__ const float* w_kv() const { return (const float*)a.in[20]; }
    __device__ __forceinline__ const float* g_k_b() const { return (const float*)a.in[21]; }
    __device__ __forceinline__ const float* w_q_b() const { return (const float*)a.in[22]; }
    __device__ __forceinline__ const float* g_q_b() const { return (const float*)a.in[23]; }
    __device__ __forceinline__ const float* sinks() const { return (const float*)a.in[24]; }
    __device__ __forceinline__ const float* w_b_out() const { return (const float*)a.in[25]; }
    __device__ __forceinline__ const float* w_ffn_in() const { return (const float*)a.in[26]; }
    __device__ __forceinline__ const float* w_ffn_out() const { return (const float*)a.in[27]; }
    template <class Tp> __device__ __forceinline__ Tp* p(size_t off) const { return (Tp*)(ws + off); }
};

__device__ __forceinline__ void p0_item(const float* W, int ldw, int K, bf16_t* WT, int d0, int s0, const float* gain, int kb, LAS float* scr, int lane) {
    const int k0 = 64 * kb;
#pragma unroll
    for (int u = 0; u < 8; ++u) { const int idx = lane + 64 * u, kk = idx >> 3, n4 = (idx & 7) * 4;
        f32x4 v = {0.f, 0.f, 0.f, 0.f}; if (s0 >= 0) { v = __builtin_nontemporal_load((const f32x4*)(W + (size_t)(k0 + kk) * ldw + s0 + n4));     if (gain) v *= gain[k0 + kk]; }
        LAS float* d = scr + kk * 33 + n4; d[0] = v[0]; d[1] = v[1]; d[2] = v[2]; d[3] = v[3]; }
    asm volatile("s_waitcnt lgkmcnt(0)" ::: "memory");
    const int c = lane & 7;
#pragma unroll
    for (int j = 0; j < 4; ++j) { const int n = (lane >> 3) + 8 * j; const LAS float* s = scr + (8 * c) * 33 + n;
        u32x4 o; o.x = pk2(s[0 * 33], s[1 * 33]); o.y = pk2(s[2 * 33], s[3 * 33]); o.z = pk2(s[4 * 33], s[5 * 33]); o.w = pk2(s[6 * 33], s[7 * 33]);
        *(u32x4*)(WT + (size_t)(d0 + n) * K + k0 + 8 * c) = o; }
    asm volatile("s_waitcnt lgkmcnt(0)" ::: "memory");
}
__device__ __forceinline__ void p0_job(const Ctx& C, LAS float* scr, const float* W, int ldw, int K, int nd, bf16_t* WT, int drow0, const float* gain, int map, int nsrc, int& base) {
    const int nblk = nd / 32, nit = (K / 64) * nblk;
    int it0 = C.gw - (base % C.ngw); if (it0 < 0) it0 += C.ngw;
    for (int it = it0; it < nit; it += C.ngw) {
        const int kb = it / nblk, nb = it % nblk, d0 = 32 * nb;
        int s0 = d0;
        const int pn = d0 >> 8, c0 = d0 & 255, mbj = c0 >> 7, mwc = (c0 >> 5) & 3;
        if (map == 1) s0 = (c0 < 128) ? 128 * pn + c0 : 2816 + 128 * pn + (c0 - 128);
        else if (map == 2) s0 = (pn < 4) ? (4 * pn + mwc) * 96 + 32 * mbj : (8 * (pn - 4) + 4 * mbj + mwc) * 96 + 64;
        else if (map == 3) s0 = (4 * pn + mwc) * 64 + 32 * mbj;
        else if (map == 4) s0 = (pn == 0) ? mwc * 64 + 32 * mbj : d0;
        else if (map == 5) s0 = (d0 < 384) ? d0 : (d0 == 384 ? 640 : (d0 < 512 ? 1 << 20 : d0 - 128));
        if (s0 >= nsrc) s0 = -1;
        p0_item(W, ldw, K, WT, drow0 + d0, s0, gain, kb, scr, C.lane);
    }
    base += nit;
}
__device__ __forceinline__ void p0_prologue(const Ctx& C) {
    LAS float* scr = (LAS float*)(C.lds + C.wave * 16384);
    int base = 0;
    p0_job(C, scr, C.w_a_in(), 672, 1024, 768, C.p<bf16_t>(WS_WAIN), 0, C.norm_attn(), 5, 672, base);
    p0_job(C, scr, C.w_uq(), 1536, 384, 1536, C.p<bf16_t>(WS_WUQ), 0, nullptr, 2, 1536, base);
    p0_job(C, scr, C.w_uk(), 1024, 256, 1024, C.p<bf16_t>(WS_WUK), 0, nullptr, 3, 1024, base);
    p0_job(C, scr, C.w_uv(), 1024, 256, 1024, C.p<bf16_t>(WS_WUV), 0, nullptr, 0, 1024, base);
    p0_job(C, scr, C.w_a_out(), 1024, 1024, 1024, C.p<bf16_t>(WS_WAOUT), 0, nullptr, 0, 1024, base);
    p0_job(C, scr, C.w_ffn_in(), 5632, 1024, 5632, C.p<bf16_t>(WS_WFIN0), 0, C.norm_ffn(), 1, 5632, base);
    p0_job(C, scr, C.w_ffn_in() + (size_t)1024 * 5632, 5632, 1024, 5632, C.p<bf16_t>(WS_WFIN1), 0, C.norm_ffn() + 1024, 1, 5632, base);
    p0_job(C, scr, C.w_ffn_out(), 1024, 2816, 1024, C.p<bf16_t>(WS_WFOUT0), 0, nullptr, 0, 1024, base);
    p0_job(C, scr, C.w_ffn_out() + (size_t)2816 * 1024, 1024, 2816, 1024, C.p<bf16_t>(WS_WFOUT1), 0, nullptr, 0, 1024, base);
    p0_job(C, scr, C.w_kv(), 512, 1024, 512, C.p<bf16_t>(WS_WKVQ), 0, C.g_kv(), 4, 512, base);
    p0_job(C, scr, C.w_q_b(), 1024, 1024, 1024, C.p<bf16_t>(WS_WKVQ), 512, C.norm_attn() + 1024, 3, 1024, base);
    p0_job(C, scr, C.w_b_out(), 1024, 1024, 1024, C.p<bf16_t>(WS_WBOUT), 0, nullptr, 0, 1024, base);
    { float* cosA = C.p<float>(WS_ROPE); float* sinA = cosA + NPOS * 16; float* cosB = sinA + NPOS * 16; float* sinB = cosB + NPOS * 8;
      for (int i = C.gw * 64 + C.lane; i < NPOS * 16; i += C.ngw * 64) {
          const int p = i / 16, j = i % 16; const float pos = (float)(p < SEQ ? p : PAST + (p - SEQ));
          { const float inv = (float)pow(500000.0, -(double)(2 * j) / 32.0); const float ang = pos * inv; cosA[i] = (float)cos((double)ang); sinA[i] = (float)sin((double)ang); }
          if (j < 8) { const float inv = (float)pow(500000.0, -(double)(2 * j) / 16.0); const float ang = pos * inv; cosB[p * 8 + j] = (float)cos((double)ang); sinB[p * 8 + j] = (float)sin((double)ang); }
      } }
    { float* ssz = C.p<float>(WS_SS); for (int i = C.gw * 64 + C.lane; i < 5 * T; i += C.ngw * 64) ssz[i] = 0.f; }
    { float* out_wks = C.out + (size_t)T * DM + (size_t)T * DCKV + (size_t)2 * NB * WIN * 256; float* out_wvs = out_wks + (size_t)DB * WIN * 256;
      for (size_t i = (size_t)C.gw * 64 + C.lane; i < (size_t)DB * (WIN - DS) * 256; i += (size_t)C.ngw * 64) { const size_t b = i / ((WIN - DS) * 256), r = i % ((WIN - DS) * 256);
          out_wks[b * WIN * 256 + r] = C.swk()[b * WIN * 256 + DS * 256 + r]; out_wvs[b * WIN * 256 + r] = C.swv()[b * WIN * 256 + DS * 256 + r]; } }
    if (C.gw == 0) {
        float a = fabsf(C.g_qn()[C.lane]), b = fabsf(C.g_kn()[C.lane]), c = C.lane < 32 ? fabsf(C.g_qr()[C.lane]) : 0.f, d = C.lane < 32 ? fabsf(C.g_kr()[C.lane]) : 0.f;
        float e = fabsf(C.g_q_b()[C.lane]), f = fabsf(C.g_k_b()[C.lane]), s = C.lane < 16 ? C.sinks()[C.lane] : -1e30f;
#pragma unroll
        for (int o = 1; o < 64; o <<= 1) { a = fmaxf(a, __shfl_xor(a, o)); b = fmaxf(b, __shfl_xor(b, o)); c = fmaxf(c, __shfl_xor(c, o)); d = fmaxf(d, __shfl_xor(d, o));
            e = fmaxf(e, __shfl_xor(e, o)); f = fmaxf(f, __shfl_xor(f, o)); s = fmaxf(s, __shfl_xor(s, o)); }
        if (C.lane == 0) { float* bnd = C.p<float>(WS_BND); bnd[0] = SCALE_A * LOG2E * (64.f * a * b + 32.f * c * d) * 1.02f; bnd[1] = fmaxf(SCALE_B * LOG2E * 64.f * e * f * 1.02f, s * LOG2E); }
    }
}
__device__ __forceinline__ void norm_row_bf16(const float* xrow, bf16_t* orow, int lane) {
    const f32x4* xr = (const f32x4*)xrow + lane; f32x4 v[4]; float s = 0.f;
#pragma unroll
    for (int j = 0; j < 4; ++j) { v[j] = __builtin_nontemporal_load(xr + 64 * j); s += (v[j].x * v[j].x + v[j].y * v[j].y) + (v[j].z * v[j].z + v[j].w * v[j].w); }
    const float r = rsqrtf(wave_sum(s) * (1.f / DM) + EPS);
    u32x2* o = (u32x2*)orow + lane;
#pragma unroll
    for (int j = 0; j < 4; ++j) o[64 * j] = (u32x2){pk2(v[j].x * r, v[j].y * r), pk2(v[j].z * r, v[j].w * r)};
}
__device__ __forceinline__ void p_norm_x(const Ctx& C) {
    bf16_t* hb = C.p<bf16_t>(WS_HB);
    for (int t = C.gw; t < T; t += C.ngw) norm_row_bf16(t < TP ? C.x_prompt() + (size_t)t * DM : C.x_sample() + (size_t)(t - TP) * DM, hb + (size_t)t * DM, C.lane);
}
__device__ __forceinline__ void p_norm_h(const Ctx& C, const float* H) {
    bf16_t* hb = C.p<bf16_t>(WS_HB);
    for (int t = C.gw; t < T; t += C.ngw) norm_row_bf16(H + (size_t)t * DM, hb + (size_t)t * DM, C.lane);
}
__device__ __forceinline__ void p_rows_out(const Ctx& C) {
    const bf16_t* CKV = C.p<bf16_t>(WS_CKV); const float* sskv = C.p<float>(WS_SS) + 4 * T; float* ROWS = C.out + (size_t)T * DM; const int lane = lane_id_fresh();
    for (int t0 = 4 * C.gw; t0 < T; t0 += 4 * C.ngw) {
        u32x2 w[4]; float r[4];
#pragma unroll
        for (int i = 0; i < 4; ++i) { w[i] = *(const u32x2*)(CKV + (size_t)(t0 + i) * DC + 4 * lane); r[i] = sskv[t0 + i]; }
#pragma unroll
        for (int i = 0; i < 4; ++i) { const float rr = rsqrtf(r[i] * (1.f / DC) + EPS);
            *(f32x4*)(ROWS + (size_t)(t0 + i) * DCKV + 4 * lane) = (f32x4){bflo(w[i].x), bfhi(w[i].x), bflo(w[i].y), bfhi(w[i].y)} * rr; }
    }
}
__device__ __forceinline__ void p_post_a(const Ctx& C) {
    const float* AF = C.p<float>(WS_AF); bf16_t* CQ = C.p<bf16_t>(WS_CQ); bf16_t* CKV = C.p<bf16_t>(WS_CKV); bf16_t* KPE = C.p<bf16_t>(WS_KPE);
    float* ROWS = C.out + (size_t)T * DM; const float* cosA = C.p<float>(WS_ROPE); const float* sinA = cosA + NPOS * 16; const int lane = C.lane;
    for (int t = C.gw; t < T; t += C.ngw) {
        const float* a = AF + (size_t)t * 768;
        float q[6]; float s = 0.f;
#pragma unroll
        for (int i = 0; i < 6; ++i) { q[i] = a[lane + 64 * i]; s += q[i] * q[i]; }
        float r = rsqrtf(wave_sum(s) * (1.f / DQC) + EPS);
#pragma unroll
        for (int i = 0; i < 6; ++i) CQ[(size_t)t * DQC + lane + 64 * i] = (bf16_t)f2bf(q[i] * r * C.g_qc()[lane + 64 * i]);
        float k[4]; s = 0.f;
#pragma unroll
        for (int i = 0; i < 4; ++i) { k[i] = a[DQC + lane + 64 * i]; s += k[i] * k[i]; }
        r = rsqrtf(wave_sum(s) * (1.f / DC) + EPS);
#pragma unroll
        for (int i = 0; i < 4; ++i) { const float v = k[i] * r * C.g_ckv()[lane + 64 * i]; ROWS[(size_t)t * DCKV + lane + 64 * i] = v; CKV[(size_t)t * DC + lane + 64 * i] = (bf16_t)f2bf(v); }
        const float v = lane < 32 ? a[DQC + DC + lane] : 0.f;
        r = rsqrtf(wave_sum(v * v) * (1.f / 32) + EPS);
        const float vn = lane < 32 ? v * r * C.g_kr()[lane] : 0.f, other = __shfl_xor(vn, 16);
        const int p = tok_pidx(t), j = lane & 15; const float c = cosA[p * 16 + j], sn = sinA[p * 16 + j];
        const float o = (lane < 16) ? (vn * c - other * sn) : (vn * c + other * sn);
        if (lane < 32) { ROWS[(size_t)t * DCKV + DC + lane] = o; KPE[(size_t)t * 32 + lane] = (bf16_t)f2bf(o); }
    }
}
}
namespace mk {
__device__ __forceinline__ bf16x8 pack8(float a0, float a1, float a2, float a3, float a4, float a5, float a6, float a7) {
    u32x4 w = {pk2(a0, a1), pk2(a2, a3), pk2(a4, a5), pk2(a6, a7)}; return __builtin_bit_cast(bf16x8, w); }
#define MFMA32(a, b, c) __builtin_amdgcn_mfma_f32_32x32x16_bf16((a), (b), (c), 0, 0, 0)
__device__ __forceinline__ f32x16 zero16() { f32x16 z;
#pragma unroll
    for (int i = 0; i < 16; ++i) z[i] = 0.f; return z; }

constexpr int AT_KP = 208, AT_VP = 192, AT_KBYTES = 64 * AT_KP, AT_VBYTES = 64 * AT_VP, AT_BUF = AT_KBYTES + AT_VBYTES;
typedef short v4i16_t __attribute__((ext_vector_type(4)));
__device__ __forceinline__ void mla_attn_unit(const Ctx& C, int b, int h, int qb, float bnd, u32x4& rkA, u32x4& rrA, u32x4& rvA, u32x4& rkB, u32x4& rrB, u32x4& rvB, bool preloaded, int nb, int nh) {
    const int tid = C.tid, lane = C.lane, w = C.wave, l31 = lane & 31, hh = lane >> 5;
    const bf16_t* QF = C.p<bf16_t>(WS_QF); const bf16_t* KN = C.p<bf16_t>(WS_KN); const bf16_t* KPE = C.p<bf16_t>(WS_KPE); const bf16_t* KNV = C.p<bf16_t>(WS_KNRAW); bf16_t* O = C.p<bf16_t>(WS_O);
    const size_t tokq = (size_t)b * SEQ + qb * 256 + 32 * w + l31;
    bf16x8 qf[6];
    { const bf16_t* qp = QF + (tokq * 16 + h) * 96 + 8 * hh;
#pragma unroll
      for (int s = 0; s < 6; ++s) qf[s] = *(const bf16x8*)(qp + 16 * s); }
    f32x16 oT[2]; oT[0] = zero16(); oT[1] = zero16(); float lsum = 0.f;
    f32x16 negb;
#pragma unroll
    for (int i = 0; i < 16; ++i) negb[i] = -bnd;
    const int ntile = 4 * (qb + 1), mylast = 4 * qb + (w >> 1);
    const bf16_t* gK = KN + ((size_t)b * SEQ + (tid >> 3)) * 1024 + h * 64 + (tid & 7) * 8;
    const bf16_t* gR = KPE + ((size_t)b * SEQ + ((tid & 255) >> 2)) * 32 + (tid & 3) * 8;
    const bf16_t* gV = KNV + ((size_t)b * SEQ + (tid >> 3)) * 2048 + 1024 + h * 64 + (tid & 7) * 8;
    const unsigned sK = (tid >> 3) * AT_KP + (tid & 7) * 16, sR = ((tid & 255) >> 2) * AT_KP + 128 + (tid & 3) * 16, sV = AT_KBYTES + (tid >> 3) * AT_VP + (tid & 7) * 16;
    const long dK = (long)(nb - b) * SEQ * 1024 + (nh - h) * 64, dR = (long)(nb - b) * SEQ * 32, dV = (long)(nb - b) * SEQ * 2048 + (nh - h) * 64;
#define AT_LOAD(K_, R_, V_, t_) do { K_ = *(const u32x4*)(gK + (size_t)(t_) * 64 * 1024); if (tid < 256) R_ = *(const u32x4*)(gR + (size_t)(t_) * 64 * 32); V_ = *(const u32x4*)(gV + (size_t)(t_) * 64 * 2048); } while (0)
#define AT_STORE(K_, R_, V_, b_) do { LAS unsigned char* d_ = C.lds + (b_) * AT_BUF; *(LAS u32x4*)(d_ + sK) = K_; if (tid < 256) *(LAS u32x4*)(d_ + sR) = R_; *(LAS u32x4*)(d_ + sV) = V_; } while (0)
#define AT_LOAD_N(K_, R_, V_, t_) do { K_ = *(const u32x4*)(gK + dK + (size_t)(t_) * 64 * 1024); if (tid < 256) R_ = *(const u32x4*)(gR + dR + (size_t)(t_) * 64 * 32); V_ = *(const u32x4*)(gV + dV + (size_t)(t_) * 64 * 2048); } while (0)
    if (!preloaded) { AT_LOAD(rkA, rrA, rvA, 0); AT_LOAD(rkB, rrB, rvB, 1); }
    AT_STORE(rkA, rrA, rvA, 0);
    __syncthreads();
    const int tr_off = (4 * hh + ((lane & 15) >> 2)) * AT_VP + (16 * ((lane >> 4) & 1) + 4 * (lane & 3)) * 2;
    int cur = 0;
    const bool grpB = w >= 4;
#define AT_STEP(LK_, LR_, LV_, SK_, SR_, SV_) do { const int nb1 = cur == 2 ? 0 : cur + 1; \
        if (jt + 2 < ntile) AT_LOAD(LK_, LR_, LV_, jt + 2); else if (nb >= 0) AT_LOAD_N(LK_, LR_, LV_, jt + 2 - ntile); \
        at_S(jt); \
        if (grpB) { if (jt + 1 < ntile) AT_STORE(SK_, SR_, SV_, nb1); __syncthreads(); } \
        __builtin_amdgcn_s_setprio(2); at_PV(jt); __builtin_amdgcn_s_setprio(0); \
        if (!grpB) { if (jt + 1 < ntile) AT_STORE(SK_, SR_, SV_, nb1); __syncthreads(); } \
        cur = nb1; ++jt; } while (0)
    f32x16 p0, p1;
    auto at_S = [&](int jt) __attribute__((always_inline)) {
        if (jt <= mylast) {
            const LAS unsigned char* kb = C.lds + cur * AT_BUF + l31 * AT_KP + hh * 16;
            p0 = negb; p1 = negb;
#pragma unroll
            for (int s = 0; s < 6; ++s) { const bf16x8 a0 = *(const LAS bf16x8*)(kb + s * 32), a1 = *(const LAS bf16x8*)(kb + 32 * AT_KP + s * 32);
                p0 = MFMA32(a0, qf[s], p0); p1 = MFMA32(a1, qf[s], p1); }
        }
    };
    auto at_PV = [&](int jt) __attribute__((always_inline)) {
        if (jt <= mylast) {
            const bool diag = (jt == mylast); const int qrel = 32 * (w & 1) + l31;
            float e0[16], e1[16];
#pragma unroll
            for (int r = 0; r < 16; ++r) { const int kk = (r & 3) + 8 * (r >> 2) + 4 * hh;
                e0[r] = __builtin_amdgcn_exp2f(p0[r]); e1[r] = __builtin_amdgcn_exp2f(p1[r]);
                if (diag) { if (kk > qrel) e0[r] = 0.f; if (kk + 32 > qrel) e1[r] = 0.f; }
                lsum += e0[r] + e1[r]; }
            bf16x8 pb[2][2];
            pb[0][0] = pack8(e0[0], e0[1], e0[2], e0[3], e0[4], e0[5], e0[6], e0[7]); pb[0][1] = pack8(e0[8], e0[9], e0[10], e0[11], e0[12], e0[13], e0[14], e0[15]);
            pb[1][0] = pack8(e1[0], e1[1], e1[2], e1[3], e1[4], e1[5], e1[6], e1[7]); pb[1][1] = pack8(e1[8], e1[9], e1[10], e1[11], e1[12], e1[13], e1[14], e1[15]);
            const LAS unsigned char* vb = C.lds + cur * AT_BUF + AT_KBYTES + tr_off;
#pragma unroll
            for (int dt = 0; dt < 2; ++dt)
#pragma unroll
                for (int kh = 0; kh < 2; ++kh)
#pragma unroll
                    for (int ks = 0; ks < 2; ++ks) { const LAS unsigned char* ad = vb + (32 * kh + 16 * ks) * AT_VP + dt * 64;
                        const v4i16_t lo = __builtin_amdgcn_ds_read_tr16_b64_v4i16((LAS v4i16_t*)ad), hi = __builtin_amdgcn_ds_read_tr16_b64_v4i16((LAS v4i16_t*)(ad + 8 * AT_VP));
                        const bf16x8 av = {lo[0], lo[1], lo[2], lo[3], hi[0], hi[1], hi[2], hi[3]};
                        oT[dt] = MFMA32(av, pb[kh][ks], oT[dt]); }
        }
    };
    for (int jt = 0; jt < ntile;) {
        AT_STEP(rkA, rrA, rvA, rkB, rrB, rvB);
        AT_STEP(rkB, rrB, rvB, rkA, rrA, rvA);
    }
#undef AT_STEP
#undef AT_LOAD
#undef AT_LOAD_N
#undef AT_STORE
    __syncthreads();
    lsum += __shfl_xor(lsum, 32); const float inv = 1.f / lsum;
    bf16_t* op = O + tokq * 1024 + h * 64 + 4 * hh;
#pragma unroll
    for (int dt = 0; dt < 2; ++dt)
#pragma unroll
        for (int g = 0; g < 4; ++g) *(u32x2*)(op + 32 * dt + 8 * g) = (u32x2){pk2(oT[dt][4 * g] * inv, oT[dt][4 * g + 1] * inv), pk2(oT[dt][4 * g + 2] * inv, oT[dt][4 * g + 3] * inv)};
}
__device__ __forceinline__ void p_mla_attn_prompt(const Ctx& C) {
    const float bnd = C.p<float>(WS_BND)[0];
    u32x4 rkA, rrA = {0u, 0u, 0u, 0u}, rvA, rkB, rrB = {0u, 0u, 0u, 0u}, rvB; bool pre = false;
    for (int u = blockIdx.x; u < NB * HA * 4; u += gridDim.x) {
        const int j = u & 3, h = (u >> 2) & 15, b = u >> 6, un = u + gridDim.x;
        const int nb2 = un < NB * HA * 4 ? (un >> 6) : -1, nh2 = (un >> 2) & 15;
        mla_attn_unit(C, b, h, 7 - j, bnd, rkA, rrA, rvA, rkB, rrB, rvB, pre, b, h); pre = true;
        mla_attn_unit(C, b, h, j, bnd, rkA, rrA, rvA, rkB, rrB, rvB, true, nb2, nh2);
    }
}

constexpr int SW_KP = 144, SW_VP = 192, SW_KBYTES = 256 * SW_KP;
struct SwaRegs { u32x4 k[4], v[4]; };
__device__ __forceinline__ void swa_load(const Ctx& C, int u, SwaRegs& R) {
    const int blk = u & 15, kvh = (u >> 4) & 3, b = u >> 6, tid = C.tid, kpos0 = 128 * (blk - 1);
    const bf16_t* KS = C.p<bf16_t>(WS_KS); const bf16_t* VSB = C.p<bf16_t>(WS_VS);
#pragma unroll
    for (int q = 0; q < 4; ++q) { const int i = tid + 512 * q, key = i >> 3, c = i & 7; const u32x4 z = {0u, 0u, 0u, 0u}; R.k[q] = z; R.v[q] = z;
        if (kpos0 + key >= 0) { const size_t o = ((size_t)b * SEQ + kpos0 + key) * 256 + kvh * 64 + c * 8; R.k[q] = *(const u32x4*)(KS + o); R.v[q] = *(const u32x4*)(VSB + o); } }
}
__device__ __forceinline__ void swa_store(const Ctx& C, const SwaRegs& R) {
    const int tid = C.tid;
#pragma unroll
    for (int q = 0; q < 4; ++q) { const int i = tid + 512 * q, key = i >> 3, c = i & 7;
        *(LAS u32x4*)(C.lds + key * SW_KP + c * 16) = R.k[q]; *(LAS u32x4*)(C.lds + SW_KBYTES + key * SW_VP + c * 16) = R.v[q]; }
}
__device__ __forceinline__ void swa_compute(const Ctx& C, int u, float bnd) {
    const int blk = u & 15, kvh = (u >> 4) & 3, b = u >> 6;
    const int lane = C.lane, w = C.wave, l31 = lane & 31, hh = lane >> 5;
    const bf16_t* QF = C.p<bf16_t>(WS_QBF); bf16_t* O = C.p<bf16_t>(WS_O);
    const int g = w >> 1, qh = w & 1, head = 4 * kvh + g;
    const float sk = __builtin_amdgcn_exp2f(C.sinks()[head] * LOG2E - bnd);
#pragma unroll 1
    for (int rg = 0; rg < 2; ++rg) {
        const int qr0 = 64 * qh + 32 * rg + l31; const size_t tok = (size_t)b * SEQ + 128 * blk + qr0;
        bf16x8 qf[4];
#pragma unroll
        for (int s = 0; s < 4; ++s) qf[s] = *(const bf16x8*)(QF + tok * 1024 + head * 64 + 16 * s + 8 * hh);
        f32x16 oT[2]; oT[0] = zero16(); oT[1] = zero16(); float lsum = 0.f;
        int kt0 = qh ? 1 : 0; const int kt1 = qh ? 3 : 2; if (blk == 0 && kt0 < 2) kt0 = 2;
#pragma unroll 1
        for (int kt = kt0; kt <= kt1; ++kt) {
            const LAS unsigned char* kb = C.lds + (64 * kt + l31) * SW_KP + hh * 16;
            f32x16 p0 = zero16(), p1 = zero16();
#pragma unroll
            for (int s = 0; s < 4; ++s) { const bf16x8 a0 = *(const LAS bf16x8*)(kb + s * 32), a1 = *(const LAS bf16x8*)(kb + 32 * SW_KP + s * 32);
                p0 = MFMA32(a0, qf[s], p0); p1 = MFMA32(a1, qf[s], p1); }
            float e0[16], e1[16];
#pragma unroll
            for (int r = 0; r < 16; ++r) { const int kk = 64 * kt + (r & 3) + 8 * (r >> 2) + 4 * hh;
                e0[r] = (kk > qr0 && kk <= qr0 + 128) ? __builtin_amdgcn_exp2f(p0[r] - bnd) : 0.f;
                e1[r] = (kk + 32 > qr0 && kk + 32 <= qr0 + 128) ? __builtin_amdgcn_exp2f(p1[r] - bnd) : 0.f;
                lsum += e0[r] + e1[r]; }
            bf16x8 pb[2][2];
            pb[0][0] = pack8(e0[0], e0[1], e0[2], e0[3], e0[4], e0[5], e0[6], e0[7]); pb[0][1] = pack8(e0[8], e0[9], e0[10], e0[11], e0[12], e0[13], e0[14], e0[15]);
            pb[1][0] = pack8(e1[0], e1[1], e1[2], e1[3], e1[4], e1[5], e1[6], e1[7]); pb[1][1] = pack8(e1[8], e1[9], e1[10], e1[11], e1[12], e1[13], e1[14], e1[15]);
            const LAS unsigned char* vb = C.lds + SW_KBYTES + (64 * kt + 4 * hh + ((lane & 15) >> 2)) * SW_VP + (16 * ((lane >> 4) & 1) + 4 * (lane & 3)) * 2;
#pragma unroll
            for (int dt = 0; dt < 2; ++dt)
#pragma unroll
                for (int kh = 0; kh < 2; ++kh)
#pragma unroll
                    for (int ks = 0; ks < 2; ++ks) { const LAS unsigned char* ad = vb + (32 * kh + 16 * ks) * SW_VP + dt * 64;
                        const v4i16_t lo = __builtin_amdgcn_ds_read_tr16_b64_v4i16((LAS v4i16_t*)ad), hi = __builtin_amdgcn_ds_read_tr16_b64_v4i16((LAS v4i16_t*)(ad + 8 * SW_VP));
                        const bf16x8 av = {lo[0], lo[1], lo[2], lo[3], hi[0], hi[1], hi[2], hi[3]};
                        oT[dt] = MFMA32(av, pb[kh][ks], oT[dt]); }
        }
        lsum += __shfl_xor(lsum, 32); const float inv = 1.f / (lsum + sk);
        bf16_t* op = O + tok * 1024 + head * 64 + 4 * hh;
#pragma unroll
        for (int dt = 0; dt < 2; ++dt)
#pragma unroll
            for (int gg = 0; gg < 4; ++gg) *(u32x2*)(op + 32 * dt + 8 * gg) = (u32x2){pk2(oT[dt][4 * gg] * inv, oT[dt][4 * gg + 1] * inv), pk2(oT[dt][4 * gg + 2] * inv, oT[dt][4 * gg + 3] * inv)};
    }
}
constexpr int SS_KP = 65, SS_K = 0, SS_V = 132 * SS_KP * 4, SS_Q = SS_V + 132 * 64 * 4, SS_P = SS_Q + 16 * 64 * 4;
__device__ __forceinline__ void swa_sample(const Ctx& C, float bnd) {
    const bf16_t* QF = C.p<bf16_t>(WS_QBF); const bf16_t* KS = C.p<bf16_t>(WS_KS); const bf16_t* VS = C.p<bf16_t>(WS_VS); bf16_t* O = C.p<bf16_t>(WS_O);
    const int lane = C.lane, tid = C.tid, w = C.wave;
    LAS float* Kl = (LAS float*)(C.lds + SS_K); LAS float* Vl = (LAS float*)(C.lds + SS_V); LAS float* Ql = (LAS float*)(C.lds + SS_Q); LAS float* Pl = (LAS float*)(C.lds + SS_P) + w * 192;
    for (int u = blockIdx.x; u < DB * NKV; u += gridDim.x) {
        const int b = u >> 2, kvh = u & 3;
#pragma unroll
        for (int k = 0; k < 4; ++k) { const int i = tid + 512 * k, row = i >> 4, c = (i & 15) * 4;
            const f32x4 kv = *(const f32x4*)(C.swk() + ((size_t)(b * WIN + row) * NKV + kvh) * 64 + c), vv = *(const f32x4*)(C.swv() + ((size_t)(b * WIN + row) * NKV + kvh) * 64 + c);
            Kl[row * SS_KP + c] = kv[0]; Kl[row * SS_KP + c + 1] = kv[1]; Kl[row * SS_KP + c + 2] = kv[2]; Kl[row * SS_KP + c + 3] = kv[3];
            *(LAS f32x4*)(Vl + row * 64 + c) = vv; }
        if (tid < 256) { const int j = tid >> 6, i = tid & 63; const size_t src = ((size_t)(TP + b * DS + j) * NKV + kvh) * 64 + i;
            Kl[(128 + j) * SS_KP + i] = bf2f(KS[src]); Vl[(128 + j) * 64 + i] = bf2f(VS[src]); }
#pragma unroll
        for (int k = 0; k < 2; ++k) { const int i = tid + 512 * k, r = i >> 6, dd = i & 63, g = r >> 2, tt = r & 3;
            Ql[i] = bf2f(QF[(size_t)(TP + b * DS + tt) * 1024 + (4 * kvh + g) * 64 + dd]); }
        __syncthreads();
#pragma unroll 1
        for (int rr = 0; rr < 2; ++rr) {
            const int r = 2 * w + rr, g = r >> 2, tt = r & 3, h = 4 * kvh + g;
            const LAS float* q = Ql + r * 64;
            float l = 0.f;
#pragma unroll
            for (int k = 0; k < 3; ++k) { const int j = lane + 64 * k; float p = 0.f;
                const bool ok = (j < 128) ? (j >= tt + 1) : (j - 128 <= tt);
                if (j < 132 && ok) { const LAS float* kp = Kl + j * SS_KP; float dsum = 0.f;
#pragma unroll 16
                    for (int i = 0; i < 64; ++i) dsum += q[i] * kp[i];
                    p = __builtin_amdgcn_exp2f(dsum - bnd); }
                Pl[j] = p; l += p; }
            l = wave_sum(l) + __builtin_amdgcn_exp2f(C.sinks()[h] * LOG2E - bnd);
            asm volatile("s_waitcnt lgkmcnt(0)" ::: "memory");
            float acc = 0.f;
#pragma unroll 4
            for (int j = 0; j < 132; ++j) acc += Pl[j] * Vl[j * 64 + lane];
            O[(size_t)(TP + b * DS + tt) * 1024 + h * 64 + lane] = (bf16_t)f2bf(acc / l);
            asm volatile("s_waitcnt lgkmcnt(0)" ::: "memory");
        }
        __syncthreads();
    }
}
__device__ __forceinline__ void p_swa_attn(const Ctx& C) {
    const float bnd = C.p<float>(WS_BND)[1];
    { SwaRegs R; int u = blockIdx.x; const int nu = NB * NKV * 16;
      if (u < nu) { swa_load(C, u, R); swa_store(C, R); }
      __syncthreads();
      for (; u < nu; u += gridDim.x) { const int un = u + gridDim.x;
          if (un < nu) swa_load(C, un, R);
          swa_compute(C, u, bnd);
          __syncthreads();
          if (un < nu) swa_store(C, R);
          __syncthreads(); } }
    swa_sample(C, bnd);
}

constexpr int DC_CP = 528;
constexpr int DC_CIMG = 0, DC_CIMG_BYTES = 32 * DC_CP, DC_KPE_BYTES = 32 * 80, DC_IMG = DC_CIMG_BYTES + DC_KPE_BYTES, DC_KPE = DC_CIMG + DC_CIMG_BYTES;
constexpr int DC_PP = 80, DC_PIMG = DC_CIMG + 4 * DC_IMG, DC_PIMG_BYTES = 32 * DC_PP, DC_QC = DC_PIMG + 3 * DC_PIMG_BYTES, DC_PTAB = DC_QC + 8 * 6 * 2 * 4 * 16, DC_END = DC_PTAB + 128;
static_assert(DC_END <= MISC_OFF, "decode LDS map");
constexpr int DC_NSTEP = 128;
__device__ __forceinline__ int dec_cu_of(int pairIdx, int half) { return (pairIdx & 7) | (half << 3) | ((pairIdx >> 3) << 4); }
#define DC_BAR() asm volatile("s_waitcnt lgkmcnt(0)\n\ts_barrier" ::: "memory")
__device__ __forceinline__ void dec_A(const bf16x8 (&a)[2][16], bf16x8 (&bq)[4], const LAS unsigned char* cimg, int lane, f32x16& k0, f32x16& k1) {
    const LAS unsigned char* cb = cimg + (lane & 31) * DC_CP + (lane >> 5) * 16;
    k0 = zero16(); k1 = zero16();
#pragma unroll
    for (int s = 0; s < 16; ++s) {
        k0 = MFMA32(a[0][s], bq[s & 3], k0); k1 = MFMA32(a[1][s], bq[s & 3], k1);
        if (s + 4 < 16) bq[s & 3] = *(const LAS bf16x8*)(cb + (s + 4) * 32);
    }
}
__device__ __forceinline__ void dec_H2(const Ctx& C, const f32x16& k0, const f32x16& k1, const LAS unsigned char* kpe, LAS unsigned char* pimg, int w, int lane, float bnd) {
    const int l31 = lane & 31, hh = lane >> 5;
    const LAS unsigned char* qcb = C.lds + DC_QC + ((w * 12 + hh) * 4 + (l31 & 3)) * 16;
    const LAS unsigned char* kpb = kpe + l31 * 80 + hh * 16;
    float ss = 0.f;
#pragma unroll
    for (int r = 0; r < 16; ++r) ss += k0[r] * k0[r] + k1[r] * k1[r];
    ss += __shfl_xor(ss, 32);
    const float m = ss * (1.f / 64) + EPS, rn = rsqrtf(m), irn = m * rn;
    bf16x8 X[4];
    X[0] = pack8(k0[0], k0[1], k0[2], k0[3], k0[4], k0[5], k0[6], k0[7]); X[1] = pack8(k0[8], k0[9], k0[10], k0[11], k0[12], k0[13], k0[14], k0[15]);
    X[2] = pack8(k1[0], k1[1], k1[2], k1[3], k1[4], k1[5], k1[6], k1[7]); X[3] = pack8(k1[8], k1[9], k1[10], k1[11], k1[12], k1[13], k1[14], k1[15]);
    f32x16 S = zero16();
#pragma unroll
    for (int s = 4; s < 6; ++s) S = MFMA32(*(const LAS bf16x8*)(qcb + s * 128), *(const LAS bf16x8*)(kpb + (s - 4) * 32), S);
#pragma unroll
    for (int t = 0; t < 4; ++t) S[t] *= irn;
#pragma unroll
    for (int s = 0; s < 4; ++s) S = MFMA32(*(const LAS bf16x8*)(qcb + s * 128), X[s], S);
    if (lane < 32) {
        const unsigned p01 = pk2(__builtin_amdgcn_exp2f(S[0] * rn - bnd), __builtin_amdgcn_exp2f(S[1] * rn - bnd)), p23 = pk2(__builtin_amdgcn_exp2f(S[2] * rn - bnd), __builtin_amdgcn_exp2f(S[3] * rn - bnd));
        LAS bf16_t* pp = (LAS bf16_t*)(pimg + (4 * w) * DC_PP + lane * 2);
        pp[0] = (bf16_t)(p01 & 0xffffu); pp[DC_PP / 2] = (bf16_t)(p01 >> 16); pp[2 * (DC_PP / 2)] = (bf16_t)(p23 & 0xffffu); pp[3 * (DC_PP / 2)] = (bf16_t)(p23 >> 16);
    }
}
__device__ __forceinline__ const f32x4* dec_src(const Ctx& C, int s, int tid) {
    const int page = __builtin_amdgcn_readfirstlane(*(const LAS int*)(C.lds + DC_PTAB + (s >> 2) * 4));
    return (const f32x4*)(C.cache() + ((size_t)page * PAGE + 32 * (s & 3)) * DCKV) + tid;
}
__device__ __forceinline__ const f32x4* dec_src_pg(const Ctx& C, int pg, int s, int tid) {
    const int page = __builtin_amdgcn_readfirstlane(pg);
    return (const f32x4*)(C.cache() + ((size_t)page * PAGE + 32 * (s & 3)) * DCKV) + tid;
}
#define DEC_LOAD(v, src, w) do { v[0] = (src)[0]; v[1] = (src)[512]; v[2] = (src)[1024]; v[3] = (src)[1536]; if ((w) < 4) v[4] = (src)[2048]; asm volatile("" ::: "memory"); } while (0)
__device__ __forceinline__ void dec_put(const f32x4 (&v)[5], LAS unsigned char* img, int w, const int (&po)[5]) {
#pragma unroll
    for (int u = 0; u < 5; ++u) {
        if (u < 4 || w < 4) {
            const u32x2 o = {pk2(v[u][0], v[u][1]), pk2(v[u][2], v[u][3])};
            *(LAS u32x2*)(img + po[u]) = o; }
    }
}
__device__ __forceinline__ void p_mla_decode(const Ctx& C) {
    const int tid = C.tid, lane = C.lane, w = C.wave, l31 = lane & 31, hh = lane >> 5;
    const int cu = blockIdx.x; if (cu >= 256) return;
    const int half = (cu >> 3) & 1, pairIdx = (cu & 7) | ((cu >> 4) << 3), b = pairIdx >> 2, pgbase = (pairIdx & 3) * 32, h = 8 * half + w;
    const float bnd = C.p<float>(WS_BND)[0];
    const bf16_t* QF = C.p<bf16_t>(WS_QF); const bf16_t* WUKT = C.p<bf16_t>(WS_WUK);
    const int* ptab = C.page_table() + b * NPAGES + pgbase;
    const int key0 = tid / 72, c0 = tid % 72;
    int po[5];
    { int key = key0, c4 = c0;
#pragma unroll
      for (int u = 0; u < 5; ++u) { po[u] = c4 < 64 ? key * DC_CP + c4 * 8 : DC_CIMG_BYTES + key * 80 + (c4 - 64) * 8; c4 += 8; key += 7; if (c4 >= 72) { c4 -= 72; key += 1; } } }
    if (tid < 32) *(LAS int*)(C.lds + DC_PTAB + tid * 4) = ptab[tid];
    __syncthreads();
    const bool grpB = w >= 4;
    f32x4 v[5];
    { const f32x4* src = dec_src(C, 0, tid); DEC_LOAD(v, src, w); }
    for (int idx = tid; idx < 8 * 6 * 2 * 4; idx += NTHR) {
        const int t = idx & 3, h2 = (idx >> 2) & 1, s = (idx >> 3) % 6, hl = idx / 48;
        const bf16_t* q = QF + ((size_t)(TP + b * DS + t) * 16 + 8 * half + hl) * 96; float qv[8];
#pragma unroll
        for (int j = 0; j < 8; ++j) { if (s < 4) { const int dim = 16 * s + 8 * (j >> 2) + 4 * h2 + (j & 3); qv[j] = bf2f(q[dim]) * C.g_kn()[dim]; } else qv[j] = bf2f(q[64 + 16 * (s - 4) + 8 * h2 + j]); }
        *(LAS bf16x8*)(C.lds + DC_QC + idx * 16) = pack8(qv[0], qv[1], qv[2], qv[3], qv[4], qv[5], qv[6], qv[7]);
    }
    for (int i = tid; i < 2 * DC_IMG / 16; i += NTHR) *(LAS u32x4*)(C.lds + DC_CIMG + 2 * DC_IMG + i * 16) = (u32x4){0u, 0u, 0u, 0u};
    for (int i = tid; i < 2 * DC_PIMG_BYTES / 4; i += NTHR) *(LAS unsigned*)(C.lds + DC_PIMG + DC_PIMG_BYTES + i * 4) = 0u;
    dec_put(v, C.lds + DC_CIMG, w, po);
    { const f32x4* src = dec_src(C, 1, tid); DEC_LOAD(v, src, w); }
    if (grpB) {
        dec_put(v, C.lds + DC_CIMG + DC_IMG, w, po);
        asm volatile("" ::: "memory");
        const f32x4* src = dec_src(C, 2, tid); DEC_LOAD(v, src, w);
    }
    bf16x8 a[2][16];
#pragma unroll
    for (int dt = 0; dt < 2; ++dt)
#pragma unroll
        for (int s = 0; s < 16; ++s) a[dt][s] = *(const bf16x8*)(WUKT + (size_t)(256 * (h >> 2) + 128 * dt + 32 * (h & 3) + l31) * 256 + 16 * s + 8 * hh);
    f32x16 acc = zero16(); float lrow = 0.f;
    __builtin_amdgcn_s_waitcnt(0x0F70);
    DC_BAR();
    const int trq = (8 * hh + ((lane & 15) >> 2)) * DC_CP + (32 * w + 16 * ((lane >> 4) & 1) + 4 * (lane & 3)) * 2;
    static_assert(4 * DC_CP == 2112 && 16 * DC_CP == 8448 && 20 * DC_CP == 10560, "tr-read offsets");
#define DEC_PV(T_IMG, T_P) do { \
        const LAS unsigned char* pprev_ = C.lds + DC_PIMG + (T_P) * DC_PIMG_BYTES; \
        const unsigned taddr_ = (unsigned)(unsigned long)(C.lds + DC_CIMG + (T_IMG) * DC_IMG + trq); \
        v4i16_t b00, b01, b10, b11; \
        asm volatile("ds_read_b64_tr_b16 %0, %4\n\tds_read_b64_tr_b16 %1, %4 offset:2112\n\tds_read_b64_tr_b16 %2, %4 offset:8448\n\tds_read_b64_tr_b16 %3, %4 offset:10560" \
                     : "=&v"(b00), "=&v"(b01), "=&v"(b10), "=&v"(b11) : "v"(taddr_) : "memory"); \
        const unsigned x0_ = *(const LAS unsigned*)(pprev_ + (4 * w + (lane >> 4)) * DC_PP + (lane & 15) * 4); \
        const bf16x8 pa0_ = *(const LAS bf16x8*)(pprev_ + l31 * DC_PP + hh * 16), pa1_ = *(const LAS bf16x8*)(pprev_ + l31 * DC_PP + hh * 16 + 32); \
        DEC_PV_EXTRA \
        lrow += bflo(x0_) + bfhi(x0_); \
        { const bf16x8 bb = {b00[0], b00[1], b00[2], b00[3], b01[0], b01[1], b01[2], b01[3]}; acc = MFMA32(pa0_, bb, acc); } \
        { const bf16x8 bb = {b10[0], b10[1], b10[2], b10[3], b11[0], b11[1], b11[2], b11[3]}; acc = MFMA32(pa1_, bb, acc); } } while (0)
    int p3 = 0;
#pragma unroll 1
    for (int s = 0; s < DC_NSTEP; ++s) {
        const LAS unsigned char* cimg = C.lds + DC_CIMG + (s & 3) * DC_IMG; const LAS unsigned char* kpe = cimg + DC_CIMG_BYTES;
        const int pm2 = p3 == 2 ? 0 : p3 + 1;
        bf16x8 bq[4]; f32x16 k0, k1;
        const int xn = s + 2 + (grpB ? 1 : 0);
        const int pgn = *(const LAS int*)(C.lds + DC_PTAB + ((xn >> 2) & 31) * 4);
#define DEC_PV_EXTRA { const LAS unsigned char* cb_ = cimg + l31 * DC_CP + hh * 16; bq[0] = *(const LAS bf16x8*)cb_; bq[1] = *(const LAS bf16x8*)(cb_ + 32); bq[2] = *(const LAS bf16x8*)(cb_ + 64); bq[3] = *(const LAS bf16x8*)(cb_ + 96); }
        DEC_PV((s + 2) & 3, pm2);
#undef DEC_PV_EXTRA
        dec_A(a, bq, cimg, lane, k0, k1);
        if (grpB) DC_BAR();
        __builtin_amdgcn_s_setprio(3);
        dec_H2(C, k0, k1, kpe, C.lds + DC_PIMG + p3 * DC_PIMG_BYTES, w, lane, bnd);
        { const int x = s + 1 + (grpB ? 1 : 0);
          if (x < DC_NSTEP) {
            dec_put(v, C.lds + DC_CIMG + (x & 3) * DC_IMG, w, po);
            asm volatile("" ::: "memory");
            if (x + 1 < DC_NSTEP) { const f32x4* src = dec_src_pg(C, pgn, x + 1, tid); DEC_LOAD(v, src, w); }
          } }
        __builtin_amdgcn_s_setprio(0);
        if (!grpB) DC_BAR();
        p3 = pm2;
    }
    DC_BAR();
#define DEC_PV_EXTRA
    DEC_PV((DC_NSTEP - 2) & 3, (DC_NSTEP - 2) % 3);
    DEC_PV((DC_NSTEP - 1) & 3, (DC_NSTEP - 1) % 3);
#undef DEC_PV_EXTRA
#undef DEC_PV
    float* PART = C.p<float>(WS_PART) + (size_t)cu * 32 * 256; float* PARTL = C.p<float>(WS_PARTL) + cu * 32;
    { int l2 = lane; asm volatile("" : "+v"(l2)); const int e31 = l2 & 31, eh = l2 >> 5;
#pragma unroll
    for (int r = 0; r < 16; ++r) PART[((r & 3) + 8 * (r >> 2) + 4 * eh) * 256 + 32 * w + e31] = acc[r]; }
    lrow += __shfl_xor(lrow, 1); lrow += __shfl_xor(lrow, 2); lrow += __shfl_xor(lrow, 4); lrow += __shfl_xor(lrow, 8);
    if ((lane & 15) == 0) PARTL[4 * w + (lane >> 4)] = lrow;
    __syncthreads();
}
__device__ __forceinline__ void p_mla_decode_fin(const Ctx& C) {
    const float bnd = C.p<float>(WS_BND)[0]; const int lane = C.lane, w = C.wave, qd = w & 3;
    const bf16_t* QF = C.p<bf16_t>(WS_QF); const bf16_t* KN = C.p<bf16_t>(WS_KN); const bf16_t* KPE = C.p<bf16_t>(WS_KPE); bf16_t* O = C.p<bf16_t>(WS_O);
    const float* PART = C.p<float>(WS_PART); const float* PARTL = C.p<float>(WS_PARTL); const float* ROWS = C.out + (size_t)T * DM;
    LAS float* red = (LAS float*)C.lds;
    for (int task0 = 2 * blockIdx.x; task0 < DB * HA; task0 += 2 * gridDim.x) {
        const int task = task0 + (w >> 2), h = task & 15, b = task >> 4, c = 64 * qd + lane;
        float latv[4];
#pragma unroll
        for (int t = 0; t < 4; ++t) {
            const int rho = 4 * (h & 7) + t, tok = TP + b * DS + t;
            float acc = 0.f, l = 0.f;
#pragma unroll
            for (int k = 0; k < 4; ++k) { const int cu = dec_cu_of(4 * b + k, h >> 3); acc += PART[((size_t)cu * 32 + rho) * 256 + c]; l += PARTL[cu * 32 + rho]; }
            const bf16_t* q = QF + ((size_t)tok * 16 + h) * 96;
            const float q0 = bf2f(q[lane]), q1 = lane < 32 ? bf2f(q[64 + lane]) : 0.f;
            for (int j = 0; j <= t; ++j) { const int tk = TP + b * DS + j;
                float dd = q0 * bf2f(KN[(size_t)tk * 1024 + h * 64 + lane]) + (lane < 32 ? q1 * bf2f(KPE[(size_t)tk * 32 + lane]) : 0.f);
                dd = wave_sum(dd); const float p = __builtin_amdgcn_exp2f(dd - bnd); l += p;
                acc += p * ROWS[(size_t)tk * DCKV + c]; }
            latv[t] = acc / l;
        }
        float o0 = 0.f, o1 = 0.f, o2 = 0.f, o3 = 0.f;
        const float* wp = C.w_uv() + (size_t)(64 * qd) * 1024 + h * 64 + lane;
#pragma unroll
        for (int cc = 0; cc < 64; ++cc) { const float wv = wp[(size_t)cc * 1024];
            o0 += __builtin_bit_cast(float, __builtin_amdgcn_readlane(__builtin_bit_cast(int, latv[0]), cc)) * wv; o1 += __builtin_bit_cast(float, __builtin_amdgcn_readlane(__builtin_bit_cast(int, latv[1]), cc)) * wv;
            o2 += __builtin_bit_cast(float, __builtin_amdgcn_readlane(__builtin_bit_cast(int, latv[2]), cc)) * wv; o3 += __builtin_bit_cast(float, __builtin_amdgcn_readlane(__builtin_bit_cast(int, latv[3]), cc)) * wv; }
        red[(w * 4 + 0) * 64 + lane] = o0; red[(w * 4 + 1) * 64 + lane] = o1; red[(w * 4 + 2) * 64 + lane] = o2; red[(w * 4 + 3) * 64 + lane] = o3;
        __syncthreads();
        { const int wb = w & 4; float s = 0.f;
#pragma unroll
          for (int k = 0; k < 4; ++k) s += red[((wb + k) * 4 + qd) * 64 + lane];
          O[(size_t)(TP + b * DS + qd) * 1024 + h * 64 + lane] = (bf16_t)f2bf(s); }
        __syncthreads();
    }
}
}
namespace mk {
constexpr int NPHASE = 19;
__global__ void __launch_bounds__(NTHR, 2) mk_fwd(Args a) {
    extern __shared__ __attribute__((aligned(16))) unsigned char lds_raw[];
    Ctx C{(LAS unsigned char*)lds_raw, (int)threadIdx.x, (int)(threadIdx.x & 63), __builtin_amdgcn_readfirstlane((int)(threadIdx.x >> 6)), 0, 0, a.ws, a.out, a};
    C.gw = blockIdx.x * NWAVES + C.wave; C.ngw = gridDim.x * NWAVES;
    volatile LAS unsigned* misc = (volatile LAS unsigned*)(C.lds + MISC_OFF);
    if (C.tid < 32) misc[C.tid] = 0u;
    __syncthreads();
    XcdBarrier bar = xcd_barrier_post((unsigned*)(a.ws + WS_CTL) + CW_BAR + a.li * XCD_BAR_WORDS, misc + 8);
    if (a.never) cg::this_grid().sync();
    const int lo = a.ph_lo, hi = a.ph_hi;
#ifndef PH_MASK
#define PH_MASK 0xFFFFFFu
#endif
#define IN(k) ((((PH_MASK) >> (k)) & 1u) && lo <= (k) && (k) < hi)
#ifndef REP_MASK
#define REP_MASK 0u
#endif
#define REFRESH() do { C.lane = lane_id_fresh(); C.tid = C.wave * 64 + C.lane; } while (0)
#define PH(k, ...) if (IN(k)) { REFRESH(); __VA_ARGS__ } if (IN(k) && ((((REP_MASK) >> (k)) & 1u) != 0u)) { REFRESH(); __VA_ARGS__ }
#define SEAM(k) do { if (IN(k) && (k) + 1 < hi) xcd_barrier(bar); } while (0)
#define HB C.p<bf16_t>(WS_HB)
#define ACT C.p<bf16_t>(WS_ACT)
#define O C.p<bf16_t>(WS_O)

#define XS (C.x_sample() - (size_t)TP * DM)
#ifndef REP_ATTN
#define REP_ATTN 1
#endif
#define SS1 C.p<float>(WS_SS)
#define SS2 (C.p<float>(WS_SS) + T)
#define SS3 (C.p<float>(WS_SS) + 2 * T)
    PH(0,  p0_prologue(C); p_norm_x(C); ) SEAM(0);
    PH(1,  const float* cosA = C.p<float>(WS_ROPE); FPostA f{C.p<bf16_t>(WS_CQ), C.p<bf16_t>(WS_CKV), C.p<bf16_t>(WS_KPE), C.p<float>(WS_SS) + 3 * T, C.p<float>(WS_SS) + 4 * T, C.out + (size_t)T * DM, C.g_qc(), C.g_ckv(), C.g_kr(), cosA, cosA + NPOS * 16};
        big_gemm(C.lds, HB, C.p<bf16_t>(WS_WAIN), TP, 768, 1024, f, C.wave); skinny_gemm(C.lds, HB, C.p<bf16_t>(WS_WAIN), 768, 1024, f, C.wave, C.lane, 192); ) SEAM(1);
    PH(3,
        if (!(a.flags & 16384)) { FMlaQN f{C.p<bf16_t>(WS_QF), C.g_qn(), C.p<float>(WS_SS) + 3 * T};
          big_gemm(C.lds, C.p<bf16_t>(WS_CQ), C.p<bf16_t>(WS_WUQ), TP, 1024, 384, f, C.wave); skinny_gemm(C.lds, C.p<bf16_t>(WS_CQ), C.p<bf16_t>(WS_WUQ), 1024, 384, f, C.wave, C.lane); }
        if (!(a.flags & 32768)) { const float* cosA = C.p<float>(WS_ROPE); FMlaQR f{C.p<bf16_t>(WS_QF), C.g_qr(), cosA, cosA + NPOS * 16, C.p<float>(WS_SS) + 3 * T};
          big_gemm(C.lds, C.p<bf16_t>(WS_CQ), C.p<bf16_t>(WS_WUQ) + (size_t)1024 * 384, TP, 512, 384, f, C.wave);
          skinny_gemm(C.lds, C.p<bf16_t>(WS_CQ), C.p<bf16_t>(WS_WUQ) + (size_t)1024 * 384, 512, 384, f, C.wave, C.lane, 128); }
        if (!(a.flags & 65536)) { FKnV f{C.p<bf16_t>(WS_KN), C.p<bf16_t>(WS_KNRAW), C.g_kn(), C.p<float>(WS_SS) + 4 * T}; big_gemm(C.lds, C.p<bf16_t>(WS_CKV), C.p<bf16_t>(WS_WUK), TP, 2048, 256, f, C.wave); skinny_gemm(C.lds, C.p<bf16_t>(WS_CKV), C.p<bf16_t>(WS_WUK), 1024, 256, f, C.wave, C.lane); }
        if (!(a.flags & 131072)) p_rows_out(C);
    ) SEAM(3);
    PH(5,  if (!(a.flags & 256)) { p_mla_attn_prompt(C); if (REP_ATTN > 1) p_mla_attn_prompt(C); }
           if (!(a.flags & 512)) p_mla_decode(C); ) SEAM(5);
    PH(6,  p_mla_decode_fin(C); ) SEAM(6);
    PH(7,  { FResid<0, false> f{nullptr, C.x_prompt(), HB, SS1}; big_gemm(C.lds, O, C.p<bf16_t>(WS_WAOUT), TP, 1024, 1024, f, C.wave); }
           { FResid<0, false> f{nullptr, XS, HB, SS1}; skinny_gemm(C.lds, O, C.p<bf16_t>(WS_WAOUT), 1024, 1024, f, C.wave, C.lane); } ) SEAM(7);
    PH(9,  FSwiglu f{ACT, SS1}; big_gemm(C.lds, HB, C.p<bf16_t>(WS_WFIN0), TP, 5632, 1024, f, C.wave); skinny_gemm(C.lds, HB, C.p<bf16_t>(WS_WFIN0), 5632, 1024, f, C.wave, C.lane, 128); ) SEAM(9);
    PH(10, FResid<1, false> f{nullptr, nullptr, HB, SS2}; big_gemm(C.lds, ACT, C.p<bf16_t>(WS_WFOUT0), TP, 1024, 2816, f, C.wave); skinny_gemm(C.lds, ACT, C.p<bf16_t>(WS_WFOUT0), 1024, 2816, f, C.wave, C.lane); ) SEAM(10);
    PH(12, { const float* cosB = C.p<float>(WS_ROPE) + NPOS * 32; FKvq f{C.p<bf16_t>(WS_KS), C.p<bf16_t>(WS_VS), C.p<bf16_t>(WS_QBF), SS2, C.g_k_b(), C.g_q_b(), cosB, cosB + NPOS * 8, C.out}; big_gemm(C.lds, HB, C.p<bf16_t>(WS_WKVQ), TP, 1536, 1024, f, C.wave); skinny_gemm(C.lds, HB, C.p<bf16_t>(WS_WKVQ), 1536, 1024, f, C.wave, C.lane, 128); }
 ) SEAM(12);
    PH(14, p_swa_attn(C); ) SEAM(14);
    PH(15, FResid<1, false> f{nullptr, nullptr, HB, SS3}; big_gemm(C.lds, O, C.p<bf16_t>(WS_WBOUT), TP, 1024, 1024, f, C.wave); skinny_gemm(C.lds, O, C.p<bf16_t>(WS_WBOUT), 1024, 1024, f, C.wave, C.lane); ) SEAM(15);
    PH(17, FSwiglu f{ACT, SS3}; big_gemm(C.lds, HB, C.p<bf16_t>(WS_WFIN1), TP, 5632, 1024, f, C.wave); skinny_gemm(C.lds, HB, C.p<bf16_t>(WS_WFIN1), 5632, 1024, f, C.wave, C.lane, 128); ) SEAM(17);
    PH(18, FResid<1, true> f{C.out, nullptr, HB, nullptr}; big_gemm(C.lds, ACT, C.p<bf16_t>(WS_WFOUT1), TP, 1024, 2816, f, C.wave); skinny_gemm(C.lds, ACT, C.p<bf16_t>(WS_WFOUT1), 1024, 2816, f, C.wave, C.lane); )
#undef IN
#undef HB
#undef ACT
#undef O
#undef SS1
#undef SS2
#undef SS3
#undef XS
#undef SEAM
}
static int g_grid = 0;
static void launch_phases(void* const* d_in, void* d_out, void* d_ws, hipStream_t stream, int lo, int hi, int li, int flags = 0) {
    if (g_grid == 0) {
        int dev = 0, cus = 0, per_cu = 0;
        (void)hipGetDevice(&dev); (void)hipDeviceGetAttribute(&cus, hipDeviceAttributeMultiprocessorCount, dev);
        (void)hipFuncSetAttribute((const void*)mk_fwd, hipFuncAttributeMaxDynamicSharedMemorySize, LDS_BYTES);
        (void)hipOccupancyMaxActiveBlocksPerMultiprocessor(&per_cu, (const void*)mk_fwd, NTHR, LDS_BYTES);
        (void)hipGetLastError();
        g_grid = cus * (per_cu >= 1 ? 1 : 0); if (g_grid > 256) g_grid = 256;
        if (g_grid != 256) fprintf(stderr, "kernel_launch: grid %d (cus %d per_cu %d): this kernel is written for 256 CUs\n", g_grid, cus, per_cu);
    }
    Args a{};
    for (int i = 0; i < 28; ++i) a.in[i] = d_in[i];
    a.out = (float*)d_out; a.ws = (unsigned char*)d_ws; a.ph_lo = lo; a.ph_hi = hi; a.li = li; a.never = 0; a.flags = flags;
    void* args[] = {&a};
    hipError_t e = hipLaunchCooperativeKernel((const void*)mk_fwd, dim3(g_grid), dim3(NTHR), args, LDS_BYTES, stream);
    if (e != hipSuccess) fprintf(stderr, "kernel_launch: cooperative launch failed: %s (grid %d)\n", hipGetErrorString(e), g_grid);
}
}
#ifndef MK_DEBUG
#define MK_DEBUG 0
#endif
#if MK_DEBUG
__global__ void k_bf16_to_f32(const bf16_t* in, float* out, size_t n, float scale) {
    size_t i = (size_t)blockIdx.x * blockDim.x + threadIdx.x; if (i < n) out[i] = __builtin_bit_cast(float, (unsigned)in[i] << 16) * scale; }
__global__ void k_copy_f32(const float* in, float* out, size_t n) { size_t i = (size_t)blockIdx.x * blockDim.x + threadIdx.x; if (i < n) out[i] = in[i]; }
__global__ void k_vt_to_v(const bf16_t* vt, float* V) { size_t i = (size_t)blockIdx.x * blockDim.x + threadIdx.x; if (i >= (size_t)mk::TP * 1024) return;
    size_t t = i / 1024, c = i % 1024; V[i] = __builtin_bit_cast(float, (unsigned)vt[c * mk::TP + t] << 16); }
static void cvt(hipStream_t st, const bf16_t* in, float* out, size_t n, float scale = 1.f) { hipLaunchKernelGGL(k_bf16_to_f32, dim3((unsigned)((n + 255) / 256)), dim3(256), 0, st, in, out, n, scale); }
#endif
extern "C" void kernel_launch(void* const* d_in, const int* in_sizes, int n_in, void* d_out, int out_size, void* d_ws, size_t ws_size, hipStream_t stream) {
    (void)in_sizes; (void)n_in; (void)out_size; (void)ws_size;
    (void)hipMemsetAsync((char*)d_ws + mk::WS_CTL, 0, mk::CTL_ZERO_BYTES, stream);
#if MK_DEBUG == 0
    mk::launch_phases(d_in, d_out, d_ws, stream, 0, mk::NPHASE, 0);
#else
    unsigned char* ws = (unsigned char*)d_ws; void* nvws = ws + ((size_t)1536 << 20);
    using namespace mk;
#if MK_DEBUG == 1
    nv::nv_run(d_in, d_out, nvws, stream, 2);
    launch_phases(d_in, d_out, d_ws, stream, 0, 3, 0);
#elif MK_DEBUG == 2
    nv::nv_run(d_in, d_out, nvws, stream, 0);
    launch_phases(d_in, d_out, d_ws, stream, 0, 5, 0);
    cvt(stream, (const bf16_t*)(ws + WS_QF), nv::g_nv.Q, (size_t)T * 1536, 1.f / (SCALE_A * LOG2E));
    cvt(stream, (const bf16_t*)(ws + WS_KN), nv::g_nv.KN, (size_t)T * 1024);
    hipLaunchKernelGGL(k_vt_to_v, dim3(TP * 1024 / 256), dim3(256), 0, stream, (const bf16_t*)(ws + WS_VT), nv::g_nv.V);
    nv::nv_attn_only(d_in, nvws, stream);
    nv::nv_run(d_in, d_out, nvws, stream, 1);
#elif MK_DEBUG == 3
    nv::nv_run(d_in, d_out, nvws, stream, 0);
    launch_phases(d_in, d_out, d_ws, stream, 0, 7, 0);
    cvt(stream, (const bf16_t*)(ws + WS_O), nv::g_nv.O, (size_t)T * 1024);
    nv::nv_run(d_in, d_out, nvws, stream, 1);
#elif MK_DEBUG == 4
    nv::nv_run(d_in, d_out, nvws, stream, 2);
    launch_phases(d_in, d_out, d_ws, stream, 0, 14, 0);
#elif MK_DEBUG == 6
    nv::nv_run(d_in, d_out, nvws, stream, 2);
#ifndef EXP_PHASE
#define EXP_PHASE 5
#endif
    launch_phases(d_in, d_out, d_ws, stream, 0, EXP_PHASE, 0);
#ifndef EXP_REPS
#define EXP_REPS 10
#endif
#ifndef EXP_FLAGS
#define EXP_FLAGS 0
#endif
    for (int r = 0; r < EXP_REPS; ++r) launch_phases(d_in, d_out, d_ws, stream, EXP_PHASE, EXP_PHASE + 1, 1 + r, EXP_FLAGS);
#elif MK_DEBUG == 5
    nv::nv_run(d_in, d_out, nvws, stream, 2);
    launch_phases(d_in, d_out, d_ws, stream, 0, NPHASE, 0);
#endif
#endif
}
```
